# Optimizing an MI355X kernel written in HIP

```python
import math
import jax, jax.numpy as jnp
from jax import lax
import numpy as np

D_MODEL = 1024
BATCH = 2
SEQ = 8192
DEPTH = 1

CTX_LEN = 256
GRID_W = 64
EPS = 1e-6

HG_HEADS = 4
HG_DK = 128
HG_DV = 128
HG_KDIM = HG_HEADS * HG_DK
HG_WIDTH = HG_HEADS * HG_DV
CHUNK = 32

HY_WIDTH = 512
HY_SHORT = 3
HY_EMB = 33
HY_FILTER_HIDDEN = 64
HY_FILTER_SCALE = 0.05
HY_DECAY_TARGET = 1e-2
HY_FAST_PCT = 0.3
HY_SLOW_PCT = 1.5

SPLIT_POINTS = (HG_KDIM, 2 * HG_KDIM, 3 * HG_KDIM, 3 * HG_KDIM + HG_WIDTH,
                3 * HG_KDIM + 2 * HG_WIDTH, 3 * HG_KDIM + 2 * HG_WIDTH + 3 * HY_WIDTH)
IN_WIDTH = 3 * HG_KDIM + 2 * HG_WIDTH + 3 * HY_WIDTH + 2 * D_MODEL

N_GROUPS = 4
EXPERTS_PER_GROUP = 8
TOP_K = 2
D_EXPERT = 512

kernel_name = "hybrid_hgrn2_hyena_hmoe_dit_block"

F32 = jnp.float32


def rms_norm(x, g):
    xf = x.astype(F32)
    y = xf * lax.rsqrt(jnp.mean(xf * xf, axis=-1, keepdims=True) + EPS)
    return (y * g.astype(F32)).astype(x.dtype)


def adaln(cvec, w, b):
    m = jax.nn.silu(cvec) @ w + b
    return [t[..., None, :] for t in jnp.split(m, 6, axis=-1)]


def modulate(h, shift, scale):
    return h * (1.0 + scale) + shift


def sincos_2d(n_tokens):
    rows = n_tokens // GRID_W
    r = jnp.repeat(jnp.arange(rows, dtype=F32), GRID_W)
    col = jnp.tile(jnp.arange(GRID_W, dtype=F32), rows)
    quarter = D_MODEL // 4
    omega = 1.0 / (10000.0 ** (jnp.arange(quarter, dtype=F32) / quarter))

    def axis_emb(pos):
        a = pos[:, None] * omega[None, :]
        return jnp.concatenate([jnp.sin(a), jnp.cos(a)], axis=-1)

    return jnp.concatenate([axis_emb(r), axis_emb(col)], axis=-1)


def lower_bounds(lb_param):
    p = jax.nn.softmax(lb_param.astype(F32), axis=0)
    return jnp.cumsum(p, axis=0)[:DEPTH]


def heads(t, d):
    B, L, _ = t.shape
    return t.reshape(B, L, HG_HEADS, d).transpose(0, 2, 1, 3)


def flip(t):
    return jnp.flip(t, axis=2)


def hgrn2_keys(z, lb):
    z = z.astype(F32)
    log_f = jnp.log(lb + (1.0 - lb) * jax.nn.sigmoid(z))
    k = (1.0 - lb) * jax.nn.sigmoid(-z)
    return heads(k, HG_DK), heads(log_f, HG_DK)


def gla_chunk_scan(q, k, v, log_f, s0):
    B, H, L, DK = q.shape
    DV = v.shape[-1]
    n = L // CHUNK

    def to_chunks(t):
        return t.reshape(B, H, n, CHUNK, t.shape[-1]).transpose(2, 0, 1, 3, 4)

    b = to_chunks(lax.cumsum(log_f.reshape(B, H, n, CHUNK, DK), axis=3).reshape(B, H, L, DK))
    mask = jnp.tril(jnp.ones((CHUNK, CHUNK), dtype=bool))
    mid = CHUNK // 2

    def step(S, xs):
        qc, kc, vc, bc = xs
        total = bc[:, :, -1:, :]
        ref = bc[:, :, mid:mid + 1, :]
        scores = jnp.einsum('bhtk,bhsk->bhts', qc * jnp.exp(bc - ref), kc * jnp.exp(ref - bc))
        scores = jnp.where(mask, scores, 0.0)
        o = (jnp.einsum('bhtk,bhkv->bhtv', qc * jnp.exp(bc), S)
             + jnp.einsum('bhts,bhsv->bhtv', scores, vc))
        S_new = (jnp.exp(total[:, :, 0, :])[..., None] * S
                 + jnp.einsum('bhsk,bhsv->bhkv', kc * jnp.exp(total - bc), vc))
        return S_new, o

    s_fin, o = lax.scan(step, s0, (to_chunks(q), to_chunks(k), to_chunks(v), b))
    return o.transpose(1, 2, 0, 3, 4).reshape(B, H, L, DV), s_fin


def gla_final_state(k, v, log_f):
    decay = jnp.exp(lax.cumsum(log_f, axis=2, reverse=True) - log_f)
    return jnp.einsum('bhlk,bhlv->bhkv', k * decay, v)


def hgrn2_bidir(q, v, fwd, bwd, s0_f, s0_b):
    o_f, s_f = gla_chunk_scan(q, fwd[0], v, fwd[1], s0_f)
    o_b, s_b = gla_chunk_scan(flip(q), flip(bwd[0]), flip(v), flip(bwd[1]), s0_b)
    return o_f + flip(o_b), s_f, s_b


def hgrn2_readout(o, g, norm_g, dtype):
    o = o * lax.rsqrt(jnp.mean(o * o, axis=-1, keepdims=True) + EPS) * norm_g.astype(F32)
    B, H, L, DV = o.shape
    o = o.transpose(0, 2, 1, 3).reshape(B, L, H * DV)
    return (o * jax.nn.silu(g.astype(F32))).astype(dtype)


def short_conv3(u, w, b):
    up = jnp.pad(u, ((0, 0), (1, 1), (0, 0)))
    return up[:, :-2] * w[0] + up[:, 1:-1] * w[1] + up[:, 2:] * w[2] + b


def hyena_filters(L, w1, b1, fr1, w2, b2, fr2, w3):
    t = jnp.linspace(0.0, 1.0, L, dtype=F32)[:, None]
    bands = (HY_EMB - 1) // 2
    ang = (2.0 * math.pi * jnp.arange(L, dtype=F32) / L)[:, None] * \
        jnp.linspace(1e-4, bands - 1, bands, dtype=F32)[None, :]
    z = jnp.concatenate([t, jnp.cos(ang), -jnp.sin(ang)], axis=-1)
    h = jnp.sin(fr1.astype(F32) * (z @ w1.astype(F32) + b1.astype(F32)))
    h = jnp.sin(fr2.astype(F32) * (h @ w2.astype(F32) + b2.astype(F32)))
    h = h @ w3.astype(F32)
    deltas = jnp.abs(jnp.linspace(math.log(HY_DECAY_TARGET) / HY_SLOW_PCT,
                                  math.log(HY_DECAY_TARGET) / HY_FAST_PCT, HY_WIDTH, dtype=F32))
    h = h.reshape(L, 2, HY_WIDTH) * jnp.exp(-t * deltas)[:, None, :]
    return h[:, 0], h[:, 1]


def long_conv_bidir(u, h_fwd, h_bwd, d_skip):
    B, L, C = u.shape
    kern = jnp.concatenate([h_fwd, jnp.zeros((1, C), F32), jnp.flip(h_bwd[1:], axis=0)], axis=0)
    y = jnp.fft.irfft(jnp.fft.rfft(u, n=2 * L, axis=1) * jnp.fft.rfft(kern, axis=0)[None],
                      n=2 * L, axis=1)[:, :L]
    return y + u * d_skip


def hyena_branch(p_hy, conv_w, conv_b, filt, d_skip):
    L = p_hy.shape[1]
    u = short_conv3(p_hy, conv_w, conv_b).astype(F32)
    v, x1, x0 = jnp.split(u, 3, axis=-1)
    h_fwd, h_bwd = hyena_filters(L, *filt)
    y = x0 * long_conv_bidir(v * x1, h_fwd, h_bwd, d_skip.astype(F32))
    return y.astype(p_hy.dtype)


def merge_branches(y_a, y_b, g_logits, w_pa, w_pb, w_o):
    g_a, g_b = jnp.split(g_logits, 2, axis=-1)
    mixed = jax.nn.sigmoid(g_a) * (y_a @ w_pa) + jax.nn.sigmoid(g_b) * (y_b @ w_pb)
    return mixed @ w_o


def token_mixer(p, lb, s0_f, s0_b, hg_norm_g, conv_w, conv_b, filt, d_skip, w_pa, w_pb, w_o):
    q, z_f, z_b, vi, g, p_hy, g_logits = jnp.split(p, SPLIT_POINTS, axis=-1)
    fwd = hgrn2_keys(z_f, lb[0])
    bwd = hgrn2_keys(z_b, lb[1])
    o, s_f, s_b = hgrn2_bidir(heads(q.astype(F32), HG_DK), heads(vi.astype(F32), HG_DV),
                              fwd, bwd, s0_f, s0_b)
    y_a = hgrn2_readout(o, g, hg_norm_g, p.dtype)
    y_b = hyena_branch(p_hy, conv_w, conv_b, filt, d_skip)
    return merge_branches(y_a, y_b, g_logits, w_pa, w_pb, w_o), s_f, s_b


def context_states(p_c, lb):
    z_f, z_b, vi = jnp.split(p_c, (HG_KDIM, 2 * HG_KDIM), axis=-1)
    kf, lf = hgrn2_keys(z_f, lb[0])
    kb, lb_ = hgrn2_keys(z_b, lb[1])
    v = heads(vi.astype(F32), HG_DV)
    return gla_final_state(kf, v, lf), gla_final_state(flip(kb), flip(v), flip(lb_))


def hier_moe(h, wg, bg, we, be, w_gate, w_up, w_down):
    B, L, D = h.shape
    t = h.reshape(B * L, D)
    p_group = jax.nn.softmax((t @ wg + bg).astype(F32), axis=-1)
    p_top_g, g_idx = lax.top_k(p_group, 1)
    e_logits = (jnp.einsum('td,gde->tge', t, we) + be).astype(F32)
    e_logits = jnp.take_along_axis(e_logits, g_idx[:, :, None], axis=1)[:, 0]
    p_top_e, e_idx = lax.top_k(jax.nn.softmax(e_logits, axis=-1), TOP_K)
    w_sel = p_top_g * p_top_e / jnp.sum(p_top_e, axis=-1, keepdims=True)
    combine = (jnp.einsum('tk,tke->te', w_sel, jax.nn.one_hot(e_idx, EXPERTS_PER_GROUP, dtype=F32))[:, None, :]
               * jax.nn.one_hot(g_idx[:, 0], N_GROUPS, dtype=F32)[:, :, None])
    out = jnp.zeros((B * L, D), F32)
    for gi in range(N_GROUPS):
        hid = (jax.nn.silu(jnp.einsum('td,edf->tef', t, w_gate[gi]))
               * jnp.einsum('td,edf->tef', t, w_up[gi])
               * combine[:, gi, :, None].astype(t.dtype))
        out = out + jnp.einsum('tef,efd->td', hid, w_down[gi])
    return out.reshape(B, L, D).astype(h.dtype)


def setup_inputs(seed: int = 0) -> dict:
    key = jax.random.key(seed)
    ks = jax.random.split(key, 32)

    def nrm(k, shape, scale):
        return scale * jax.random.normal(k, shape, F32)

    G, E, F = N_GROUPS, EXPERTS_PER_GROUP, D_EXPERT
    return {
        "x": nrm(ks[0], (BATCH, SEQ, D_MODEL), 1.0),
        "c": nrm(ks[1], (BATCH, D_MODEL), 1.0),
        "ctx": nrm(ks[2], (BATCH, CTX_LEN, D_MODEL), 1.0),
        "c_ctx": nrm(ks[3], (D_MODEL,), 1.0),
        "ada_w": nrm(ks[4], (DEPTH, D_MODEL, 6 * D_MODEL), 0.5 * D_MODEL ** -0.5),
        "ada_b": nrm(ks[5], (DEPTH, 6 * D_MODEL), 0.02),
        "norm1_g": 1.0 + nrm(ks[6], (DEPTH, D_MODEL), 0.05),
        "norm2_g": 1.0 + nrm(ks[7], (DEPTH, D_MODEL), 0.05),
        "w_in": nrm(ks[8], (DEPTH, D_MODEL, IN_WIDTH), D_MODEL ** -0.5),
        "hgrn_lb": nrm(ks[9], (DEPTH + 1, 2, HG_KDIM), 0.1),
        "hgrn_norm_g": 1.0 + nrm(ks[10], (DEPTH, HG_DV), 0.05),
        "hy_conv_w": nrm(ks[11], (DEPTH, HY_SHORT, 3 * HY_WIDTH), HY_SHORT ** -0.5),
        "hy_conv_b": nrm(ks[12], (DEPTH, 3 * HY_WIDTH), 0.02),
        "hy_filt_w1": nrm(ks[13], (DEPTH, HY_EMB, HY_FILTER_HIDDEN), HY_EMB ** -0.5),
        "hy_filt_b1": nrm(ks[14], (DEPTH, HY_FILTER_HIDDEN), 0.1),
        "hy_filt_freq1": 1.0 + nrm(ks[15], (DEPTH, HY_FILTER_HIDDEN), 0.1),
        "hy_filt_w2": nrm(ks[16], (DEPTH, HY_FILTER_HIDDEN, HY_FILTER_HIDDEN), HY_FILTER_HIDDEN ** -0.5),
        "hy_filt_b2": nrm(ks[17], (DEPTH, HY_FILTER_HIDDEN), 0.1),
        "hy_filt_freq2": 1.0 + nrm(ks[18], (DEPTH, HY_FILTER_HIDDEN), 0.1),
        "hy_filt_w3": nrm(ks[19], (DEPTH, HY_FILTER_HIDDEN, 2 * HY_WIDTH), HY_FILTER_SCALE * HY_FILTER_HIDDEN ** -0.5),
        "hy_d": nrm(ks[20], (DEPTH, HY_WIDTH), 0.1),
        "w_proj_a": nrm(ks[21], (DEPTH, HG_WIDTH, D_MODEL), HG_WIDTH ** -0.5),
        "w_proj_b": nrm(ks[22], (DEPTH, HY_WIDTH, D_MODEL), HY_WIDTH ** -0.5),
        "w_out": nrm(ks[23], (DEPTH, D_MODEL, D_MODEL), D_MODEL ** -0.5),
        "moe_router_g_w": nrm(ks[24], (DEPTH, D_MODEL, G), D_MODEL ** -0.5),
        "moe_router_g_b": nrm(ks[25], (DEPTH, G), 0.01),
        "moe_router_e_w": nrm(ks[26], (DEPTH, G, D_MODEL, E), D_MODEL ** -0.5),
        "moe_router_e_b": nrm(ks[27], (DEPTH, G, E), 0.01),
        "moe_w_gate": nrm(ks[28], (DEPTH, G, E, D_MODEL, F), D_MODEL ** -0.5),
        "moe_w_up": nrm(ks[29], (DEPTH, G, E, D_MODEL, F), D_MODEL ** -0.5),
        "moe_w_down": nrm(ks[30], (DEPTH, G, E, F, D_MODEL), F ** -0.5),
        "final_norm_g": 1.0 + nrm(ks[31], (D_MODEL,), 0.05),
    }


def reference(x, c, ctx, c_ctx, ada_w, ada_b, norm1_g, norm2_g, w_in, hgrn_lb, hgrn_norm_g,
              hy_conv_w, hy_conv_b, hy_filt_w1, hy_filt_b1, hy_filt_freq1, hy_filt_w2, hy_filt_b2,
              hy_filt_freq2, hy_filt_w3, hy_d, w_proj_a, w_proj_b, w_out, moe_router_g_w,
              moe_router_g_b, moe_router_e_w, moe_router_e_b, moe_w_gate, moe_w_up, moe_w_down,
              final_norm_g):
    B = x.shape[0]
    x = x + sincos_2d(x.shape[1]).astype(x.dtype)
    lbs = lower_bounds(hgrn_lb)
    zero_state = jnp.zeros((B, HG_HEADS, HG_DK, HG_DV), F32)
    for l in range(DEPTH):
        last = l == DEPTH - 1
        sh1, sc1, gt1, sh2, sc2, gt2 = adaln(c, ada_w[l], ada_b[l])
        csh1, csc1, cgt1, csh2, csc2, cgt2 = adaln(c_ctx, ada_w[l], ada_b[l])
        filt = (hy_filt_w1[l], hy_filt_b1[l], hy_filt_freq1[l], hy_filt_w2[l], hy_filt_b2[l],
                hy_filt_freq2[l], hy_filt_w3[l])
        mix_args = (hgrn_norm_g[l], hy_conv_w[l], hy_conv_b[l], filt, hy_d[l],
                    w_proj_a[l], w_proj_b[l], w_out[l])
        hc = modulate(rms_norm(ctx, norm1_g[l]), csh1, csc1)
        if last:
            s_f, s_b = context_states(hc @ w_in[l][:, HG_KDIM:3 * HG_KDIM + HG_WIDTH], lbs[l])
        else:
            ctx_mix, s_f, s_b = token_mixer(hc @ w_in[l], lbs[l], zero_state, zero_state, *mix_args)
        hx = modulate(rms_norm(x, norm1_g[l]), sh1, sc1)
        x_mix, _, _ = token_mixer(hx @ w_in[l], lbs[l], s_f, s_b, *mix_args)
        x = x + gt1 * x_mix
        moe_args = (moe_router_g_w[l], moe_router_g_b[l], moe_router_e_w[l], moe_router_e_b[l],
                    moe_w_gate[l], moe_w_up[l], moe_w_down[l])
        x = x + gt2 * hier_moe(modulate(rms_norm(x, norm2_g[l]), sh2, sc2), *moe_args)
        if not last:
            ctx = ctx + cgt1 * ctx_mix
            ctx = ctx + cgt2 * hier_moe(modulate(rms_norm(ctx, norm2_g[l]), csh2, csc2), *moe_args)
    return rms_norm(x, final_norm_g)
```

```cpp
#include <hip/hip_runtime.h>
#include <cstdio>
#include <cstdint>

namespace nv {
constexpr int NB = 2, L = 8192, D = 1024, T = NB * L, CTX = 256, TC = NB * CTX, MR = T + TC;
constexpr int INW = 6144, HK = 512, HV = 512, HYW = 512, NH = 4, DK = 128;
constexpr int C_Q = 0, C_ZF = 512, C_ZB = 1024, C_V = 1536, C_G = 2048, C_HY = 2560, C_GL = 4096;
constexpr int NG = 4, NE = 8, NEXP = 32, DF = 512;
constexpr int MAXSLOT = 34816;
constexpr float EPS = 1e-6f;
typedef unsigned short bf16_t;

__device__ __forceinline__ float bf2f(bf16_t v) { return __uint_as_float(((unsigned)v) << 16); }
__device__ __forceinline__ bf16_t f2bf(float f) { unsigned u = __float_as_uint(f); return (bf16_t)((u + 0x7fffu + ((u >> 16) & 1u)) >> 16); }
__device__ __forceinline__ float sigm(float x) { return 1.0f / (1.0f + expf(-x)); }
__device__ __forceinline__ float silu(float x) { return x * sigm(x); }

constexpr size_t MiB = 1u << 20;
constexpr size_t WS_MOD = 0;
constexpr size_t WS_LB = 128 * 1024;
constexpr size_t WS_CNT = 160 * 1024;
constexpr size_t WS_TILEE = 192 * 1024;
constexpr size_t WS_TOKE = 256 * 1024;
constexpr size_t WS_TOKW = 512 * 1024;
constexpr size_t WS_TOKS = 768 * 1024;
constexpr size_t WS_SLOTT = 1024 * 1024;
constexpr size_t WS_SLOTW = 1280 * 1024;
constexpr size_t WS_P = 4 * MiB;
constexpr size_t WS_R1 = 202 * MiB;
constexpr size_t WS_R2 = 268 * MiB;
constexpr size_t WS_END = 300 * MiB;

__global__ void k_mod(const float* c, const float* c_ctx, const float* ada_w, const float* ada_b, float* mod) {
    const int n = blockIdx.x * 256 + threadIdx.x, r = blockIdx.y;
    const float* cv = r < 2 ? c + r * D : c_ctx;
    float acc = 0.f;
    for (int k = 0; k < D; ++k) acc += silu(cv[k]) * ada_w[(size_t)k * INW + n];
    mod[r * INW + n] = acc + ada_b[n];
}
__global__ void k_lb(const float* hgrn_lb, float* lb) {
    const int i = blockIdx.x * 256 + threadIdx.x;
    const float p0 = hgrn_lb[i], p1 = hgrn_lb[1024 + i];
    lb[i] = 1.0f / (1.0f + expf(p1 - p0));
}
__global__ void k_filter(const float* w1, const float* b1, const float* fr1, const float* w2, const float* b2, const float* fr2, const float* w3, float* GN) {
    __shared__ float z[4][36], h1[4][64], h2[4][64];
    const int tid = threadIdx.x, pl = tid >> 6, j = tid & 63, i = blockIdx.x * 4 + pl;
    const float tl = (float)i / 8191.0f;
    if (j < 33) {
        float v;
        if (j == 0) v = tl;
        else {
            const int band = (j - 1) & 15;
            const float fb = 1e-4f + (float)band * ((15.0f - 1e-4f) / 15.0f);
            const float ang = (6.283185307179586f * (float)i / 8192.0f) * fb;
            v = (j <= 16) ? cosf(ang) : -sinf(ang);
        }
        z[pl][j] = v;
    }
    __syncthreads();
    { float a = b1[j]; for (int m = 0; m < 33; ++m) a += z[pl][m] * w1[m * 64 + j]; h1[pl][j] = sinf(fr1[j] * a); }
    __syncthreads();
    { float a = b2[j]; for (int m = 0; m < 64; ++m) a += h1[pl][m] * w2[m * 64 + j]; h2[pl][j] = sinf(fr2[j] * a); }
    __syncthreads();
    const float la = logf(0.01f) / 1.5f, lbb = logf(0.01f) / 0.3f;
    for (int o = 0; o < 16; ++o) {
        const int n = o * 64 + j;
        float a = 0.f; for (int m = 0; m < 64; ++m) a += h2[pl][m] * w3[m * 1024 + n];
        const int dir = n >> 9, c = n & 511;
        const float delta = fabsf(la + (float)c * ((lbb - la) / 511.0f));
        const float val = a * expf(-tl * delta);
        if (dir == 0) GN[(size_t)(8191 + i) * 512 + c] = val;
        else if (i >= 1) GN[(size_t)(8191 - i) * 512 + c] = val;
    }
}
__global__ void k_prep(const float* x, const float* ctx, const float* g1, const float* mod, float* xpos, float* hx) {
    __shared__ float red[4];
    const int row = blockIdx.x, tid = threadIdx.x;
    const bool isx = row < T;
    const float* src = isx ? x + (size_t)row * D : ctx + (size_t)(row - T) * D;
    const int mr = isx ? (row / L) : 2;
    float v[4]; float ss = 0.f;
#pragma unroll
    for (int e = 0; e < 4; ++e) {
        const int col = tid + e * 256;
        float val = src[col];
        if (isx) {
            const int t = row % L, rr = t / 64, cc = t % 64;
            const int quad = col >> 8, jj = col & 255;
            const float omega = expf(-(float)jj / 256.0f * 9.210340371976184f);
            const float pos = (quad < 2) ? (float)rr : (float)cc;
            const float a = pos * omega;
            val += (quad & 1) ? cosf(a) : sinf(a);
            xpos[(size_t)row * D + col] = val;
        }
        v[e] = val; ss += val * val;
    }
    for (int o = 32; o > 0; o >>= 1) ss += __shfl_xor(ss, o);
    if ((tid & 63) == 0) red[tid >> 6] = ss;
    __syncthreads();
    const float rs = rsqrtf((red[0] + red[1] + red[2] + red[3]) / (float)D + EPS);
#pragma unroll
    for (int e = 0; e < 4; ++e) {
        const int col = tid + e * 256;
        hx[(size_t)row * D + col] = v[e] * rs * g1[col] * (1.0f + mod[mr * INW + 1024 + col]) + mod[mr * INW + col];
    }
}

template <typename TA> __device__ __forceinline__ void load4(const TA* p, float (&o)[4]);
template <> __device__ __forceinline__ void load4<float>(const float* p, float (&o)[4]) { const float4 v = *(const float4*)p; o[0] = v.x; o[1] = v.y; o[2] = v.z; o[3] = v.w; }
template <> __device__ __forceinline__ void load4<bf16_t>(const bf16_t* p, float (&o)[4]) { const uint2 v = *(const uint2*)p; o[0] = __uint_as_float(v.x << 16); o[1] = __uint_as_float(v.x & 0xffff0000u); o[2] = __uint_as_float(v.y << 16); o[3] = __uint_as_float(v.y & 0xffff0000u); }

struct GemmArgs {
    const void* A; const void* A2; const int* rowidx;
    const float* B; const float* B2; const int* tile_expert; size_t bstride;
    int lda, ldb, K, pad;
};
template <typename TA, int NACC, bool DUALA, class Epi>
__global__ void __launch_bounds__(256) k_gemm(GemmArgs g, Epi epi) {
    __shared__ float As[NACC][16][68], Bs[NACC][16][68];
    const int tid = threadIdx.x, tx = tid & 15, ty = tid >> 4;
    const int row0 = blockIdx.y * 64, col0 = blockIdx.x * 64;
    if (g.tile_expert && g.tile_expert[blockIdx.y] < 0) return;
    const size_t boff = g.tile_expert ? (size_t)g.tile_expert[blockIdx.y] * g.bstride : 0;
    const int ar = tid >> 2, ak = (tid & 3) * 4;
    int arow = row0 + ar; if (g.rowidx) { arow = g.rowidx[arow]; if (arow < 0) arow = 0; }
    const TA* ap = (const TA*)g.A + (size_t)arow * g.lda + ak;
    const TA* ap2 = DUALA ? (const TA*)g.A2 + (size_t)arow * g.lda + ak : ap;
    const int bk = tid >> 4, bn = (tid & 15) * 4;
    const float* bp = g.B + boff + (size_t)bk * g.ldb + col0 + bn;
    const float* bp2 = NACC == 2 ? g.B2 + boff + (size_t)bk * g.ldb + col0 + bn : bp;
    float acc[NACC][4][4];
#pragma unroll
    for (int a = 0; a < NACC; ++a)
#pragma unroll
        for (int i = 0; i < 4; ++i)
#pragma unroll
            for (int j = 0; j < 4; ++j) acc[a][i][j] = 0.f;
    for (int k0 = 0; k0 < g.K; k0 += 16) {
        float av[4], av2[4]; load4<TA>(ap + k0, av); if (DUALA) load4<TA>(ap2 + k0, av2);
        const float4 bv = *(const float4*)(bp + (size_t)k0 * g.ldb);
        float4 bv2 = bv; if (NACC == 2) bv2 = *(const float4*)(bp2 + (size_t)k0 * g.ldb);
        __syncthreads();
#pragma unroll
        for (int e = 0; e < 4; ++e) { As[0][ak + e][ar] = av[e]; if (DUALA) As[NACC - 1][ak + e][ar] = av2[e]; }
        *(float4*)&Bs[0][bk][bn] = bv;
        if (NACC == 2) *(float4*)&Bs[NACC - 1][bk][bn] = bv2;
        __syncthreads();
#pragma unroll
        for (int kk = 0; kk < 16; ++kk) {
#pragma unroll
            for (int a = 0; a < NACC; ++a) {
                const float4 a4 = *(const float4*)&As[DUALA ? a : 0][kk][ty * 4];
                const float aa[4] = {a4.x, a4.y, a4.z, a4.w};
                const float4 b4 = *(const float4*)&Bs[a][kk][tx * 4];
                const float bb[4] = {b4.x, b4.y, b4.z, b4.w};
#pragma unroll
                for (int i = 0; i < 4; ++i)
#pragma unroll
                    for (int j = 0; j < 4; ++j) acc[a][i][j] += aa[i] * bb[j];
            }
        }
    }
#pragma unroll
    for (int i = 0; i < 4; ++i)
#pragma unroll
        for (int j = 0; j < 4; ++j) epi(row0 + ty * 4 + i, col0 + tx * 4 + j, acc[0][i][j], acc[NACC - 1][i][j]);
}
struct EpiStoreBf16 { bf16_t* C; long ldc; __device__ void operator()(int r, int c, float a, float) const { C[(size_t)r * ldc + c] = f2bf(a); } };
struct EpiStoreF32 { float* C; long ldc; __device__ void operator()(int r, int c, float a, float) const { C[(size_t)r * ldc + c] = a; } };
struct EpiMerge { bf16_t* MX; const bf16_t* P; __device__ void operator()(int r, int c, float a, float b) const {
    MX[(size_t)r * D + c] = f2bf(sigm(bf2f(P[(size_t)r * INW + C_GL + c])) * a + sigm(bf2f(P[(size_t)r * INW + C_GL + 1024 + c])) * b); } };
struct EpiX1 { float* X; const float* mod; __device__ void operator()(int r, int c, float a, float) const { const int b = r / L; X[(size_t)r * D + c] += mod[b * INW + 2048 + c] * a; } };
struct EpiHid { float* H; const float* slot_w; __device__ void operator()(int r, int c, float g, float u) const { H[(size_t)r * DF + c] = silu(g) * u * slot_w[r]; } };

__global__ void __launch_bounds__(64) k_gla(const bf16_t* P, const float* lb, float* O, int dir) {
    __shared__ float sf[4][128], sk[4][128], sq[4][128];
    const int lane = threadIdx.x, vh = blockIdx.x & 1, h = (blockIdx.x >> 1) & 3, b = blockIdx.x >> 3;
    const int v = vh * 64 + lane;
    float S[128];
#pragma unroll
    for (int k = 0; k < 128; ++k) S[k] = 0.f;
    const float lb0 = lb[dir * 512 + h * 128 + lane], lb1 = lb[dir * 512 + h * 128 + 64 + lane];
    const int zc = (dir == 0 ? C_ZF : C_ZB) + h * 128;
    for (int ph = 0; ph < 2; ++ph) {
        const int n = ph == 0 ? CTX : L;
        const size_t rbase = ph == 0 ? (size_t)(T + b * CTX) : (size_t)b * L;
        for (int g0 = 0; g0 < n; g0 += 4) {
            float vv[4];
#pragma unroll
            for (int j = 0; j < 4; ++j) {
                const int tt = dir == 0 ? (g0 + j) : (n - 1 - g0 - j);
                const bf16_t* pr = P + (rbase + tt) * INW;
                const float z0 = bf2f(pr[zc + lane]), z1 = bf2f(pr[zc + 64 + lane]);
                sf[j][lane] = lb0 + (1.f - lb0) * sigm(z0); sf[j][64 + lane] = lb1 + (1.f - lb1) * sigm(z1);
                sk[j][lane] = (1.f - lb0) * sigm(-z0); sk[j][64 + lane] = (1.f - lb1) * sigm(-z1);
                sq[j][lane] = bf2f(pr[C_Q + h * 128 + lane]); sq[j][64 + lane] = bf2f(pr[C_Q + h * 128 + 64 + lane]);
                vv[j] = bf2f(pr[C_V + h * 128 + v]);
            }
            __syncthreads();
#pragma unroll
            for (int j = 0; j < 4; ++j) {
                float o = 0.f;
#pragma unroll
                for (int k = 0; k < 128; k += 4) {
                    const float4 f4 = *(const float4*)&sf[j][k], k4 = *(const float4*)&sk[j][k], q4 = *(const float4*)&sq[j][k];
                    S[k] = f4.x * S[k] + k4.x * vv[j]; o += S[k] * q4.x;
                    S[k + 1] = f4.y * S[k + 1] + k4.y * vv[j]; o += S[k + 1] * q4.y;
                    S[k + 2] = f4.z * S[k + 2] + k4.z * vv[j]; o += S[k + 2] * q4.z;
                    S[k + 3] = f4.w * S[k + 3] + k4.w * vv[j]; o += S[k + 3] * q4.w;
                }
                if (ph == 1) {
                    const int tt = dir == 0 ? (g0 + j) : (n - 1 - g0 - j);
                    float* op = O + (rbase + tt) * HV + h * 128 + v;
                    if (dir == 0) *op = o; else *op += o;
                }
            }
            __syncthreads();
        }
    }
}
__global__ void __launch_bounds__(512) k_readout(const float* O, const bf16_t* P, const float* ng, float* YA) {
    __shared__ float red[8];
    const int t = blockIdx.x, c = threadIdx.x, h = c >> 7;
    const float o = O[(size_t)t * HV + c];
    float ss = o * o;
    for (int m = 32; m > 0; m >>= 1) ss += __shfl_xor(ss, m);
    if ((c & 63) == 0) red[c >> 6] = ss;
    __syncthreads();
    const float rs = rsqrtf((red[2 * h] + red[2 * h + 1]) / 128.0f + EPS);
    const float g = bf2f(P[(size_t)t * INW + C_G + c]);
    YA[(size_t)t * HV + c] = o * rs * ng[c & 127] * silu(g);
}
__device__ __forceinline__ float conv3(const bf16_t* P, int b, int t, int ch, const float* cw, const float* cb) {
    const size_t r = (size_t)b * L + t;
    float a = cb[ch] + bf2f(P[r * INW + C_HY + ch]) * cw[1536 + ch];
    if (t > 0) a += bf2f(P[(r - 1) * INW + C_HY + ch]) * cw[ch];
    if (t < L - 1) a += bf2f(P[(r + 1) * INW + C_HY + ch]) * cw[2 * 1536 + ch];
    return a;
}
__global__ void k_hy_pre(const bf16_t* P, const float* cw, const float* cb, float* U) {
    const int c = threadIdx.x + (blockIdx.x & 1) * 256, r = blockIdx.x >> 1, b = r / L, t = r % L;
    U[(size_t)r * 512 + c] = conv3(P, b, t, c, cw, cb) * conv3(P, b, t, 512 + c, cw, cb);
}
__global__ void __launch_bounds__(256) k_longconv(const float* U, const float* GN, const bf16_t* P, const float* cw, const float* cb, const float* hyd, float* YB) {
    const int tid = threadIdx.x, c = blockIdx.y * 64 + (tid & 63), tg = tid >> 6, b = blockIdx.z;
    const int tbase = blockIdx.x * 64 + tg * 16;
    float acc[16], ep[16], en[16];
#pragma unroll
    for (int i = 0; i < 16; ++i) acc[i] = 0.f;
    const float* ub = U + (size_t)b * L * 512 + c;
    const float* gb = GN + c;
#pragma unroll
    for (int m = 0; m < 16; ++m) ep[m] = gb[(size_t)(8191 + tbase + m) * 512];
    for (int s0 = 0; s0 < L; s0 += 16) {
        const int base = 8191 + tbase - s0;
#pragma unroll
        for (int n = 1; n < 16; ++n) en[n] = gb[(size_t)(base - n) * 512];
        float uv[16];
#pragma unroll
        for (int j = 0; j < 16; ++j) uv[j] = ub[(size_t)(s0 + j) * 512];
#pragma unroll
        for (int j = 0; j < 16; ++j)
#pragma unroll
            for (int i = 0; i < 16; ++i) { const int m = i - j; acc[i] += (m >= 0 ? ep[m] : en[-m]) * uv[j]; }
        if (s0 + 16 < L) {
#pragma unroll
            for (int m = 1; m < 16; ++m) ep[m] = en[16 - m];
            ep[0] = gb[(size_t)(base - 16) * 512];
        }
    }
#pragma unroll
    for (int i = 0; i < 16; ++i) {
        const int t = tbase + i; const size_t r = (size_t)b * L + t;
        const float y = acc[i] + hyd[c] * U[r * 512 + c];
        YB[r * 512 + c] = conv3(P, b, t, 1024 + c, cw, cb) * y;
    }
}
__global__ void __launch_bounds__(256) k_norm2_router(const float* X1, const float* g2, const float* mod, const float* wg, const float* bg, const float* we, const float* be,
                                                     float* H2, int* tok_e, float* tok_w, int* cnt) {
    __shared__ float red[4], part[4][8], lg[8];
    __shared__ int gsel;
    const int t = blockIdx.x, tid = threadIdx.x, b = t / L;
    float v[4], hh[4]; float ss = 0.f;
#pragma unroll
    for (int e = 0; e < 4; ++e) { v[e] = X1[(size_t)t * D + tid + e * 256]; ss += v[e] * v[e]; }
    for (int o = 32; o > 0; o >>= 1) ss += __shfl_xor(ss, o);
    if ((tid & 63) == 0) red[tid >> 6] = ss;
    __syncthreads();
    const float rs = rsqrtf((red[0] + red[1] + red[2] + red[3]) / (float)D + EPS);
#pragma unroll
    for (int e = 0; e < 4; ++e) { const int col = tid + e * 256; hh[e] = v[e] * rs * g2[col] * (1.0f + mod[b * INW + 4096 + col]) + mod[b * INW + 3072 + col]; H2[(size_t)t * D + col] = hh[e]; }
    float pg[4];
#pragma unroll
    for (int gq = 0; gq < 4; ++gq) { float a = 0.f;
#pragma unroll
        for (int e = 0; e < 4; ++e) a += hh[e] * wg[(tid + e * 256) * 4 + gq];
        for (int o = 32; o > 0; o >>= 1) a += __shfl_xor(a, o);
        pg[gq] = a; }
    if ((tid & 63) == 0) { for (int gq = 0; gq < 4; ++gq) part[tid >> 6][gq] = pg[gq]; }
    __syncthreads();
    if (tid == 0) {
        float l[4]; for (int gq = 0; gq < 4; ++gq) l[gq] = part[0][gq] + part[1][gq] + part[2][gq] + part[3][gq] + bg[gq];
        int bi = 0; for (int gq = 1; gq < 4; ++gq) if (l[gq] > l[bi]) bi = gq;
        float den = 0.f; for (int gq = 0; gq < 4; ++gq) den += expf(l[gq] - l[bi]);
        lg[0] = 1.0f / den; gsel = bi;
    }
    __syncthreads();
    const int gi = gsel; const float ptop = lg[0];
    __syncthreads();
    float pe[8];
#pragma unroll
    for (int q = 0; q < 8; ++q) { float a = 0.f;
#pragma unroll
        for (int e = 0; e < 4; ++e) a += hh[e] * we[((size_t)gi * D + tid + e * 256) * 8 + q];
        for (int o = 32; o > 0; o >>= 1) a += __shfl_xor(a, o);
        pe[q] = a; }
    if ((tid & 63) == 0) { for (int q = 0; q < 8; ++q) part[tid >> 6][q] = pe[q]; }
    __syncthreads();
    if (tid == 0) {
        float l[8]; for (int q = 0; q < 8; ++q) l[q] = part[0][q] + part[1][q] + part[2][q] + part[3][q] + be[gi * 8 + q];
        int i1 = 0; for (int q = 1; q < 8; ++q) if (l[q] > l[i1]) i1 = q;
        int i2 = -1; for (int q = 0; q < 8; ++q) if (q != i1 && (i2 < 0 || l[q] > l[i2])) i2 = q;
        const float e2 = expf(l[i2] - l[i1]);
        const int ea = gi * 8 + i1, eb = gi * 8 + i2;
        tok_e[t * 2] = ea; tok_e[t * 2 + 1] = eb;
        tok_w[t * 2] = ptop / (1.0f + e2); tok_w[t * 2 + 1] = ptop * e2 / (1.0f + e2);
        atomicAdd(&cnt[ea], 1); atomicAdd(&cnt[eb], 1);
    }
}
__global__ void k_moe_offsets(int* cnt, int* tile_expert, int* slot_tok) {
    if (threadIdx.x == 0) {
        int off = 0;
        for (int e = 0; e < NEXP; ++e) { cnt[64 + e] = off; const int nt = (cnt[e] + 63) / 64; for (int i = 0; i < nt; ++i) tile_expert[off / 64 + i] = e; off += nt * 64; }
        cnt[64 + NEXP] = off;
        for (int i = off / 64; i < MAXSLOT / 64; ++i) tile_expert[i] = -1;
    }
    __syncthreads();
    for (int i = threadIdx.x; i < MAXSLOT; i += blockDim.x) slot_tok[i] = -1;
}
__global__ void k_moe_scatter(const int* tok_e, const float* tok_w, int* cnt, int* slot_tok, float* slot_w, int* tok_slot) {
    const int i = blockIdx.x * 256 + threadIdx.x;
    const int e = tok_e[i];
    const int s = cnt[64 + e] + atomicAdd(&cnt[32 + e], 1);
    slot_tok[s] = i >> 1; slot_w[s] = tok_w[i]; tok_slot[i] = s;
}
__global__ void __launch_bounds__(256) k_final(const float* X1, const float* Y, const int* tok_slot, const float* mod, const float* fg, float* out) {
    __shared__ float red[4];
    const int t = blockIdx.x, tid = threadIdx.x, b = t / L;
    const int s0 = tok_slot[t * 2], s1 = tok_slot[t * 2 + 1];
    float v[4]; float ss = 0.f;
#pragma unroll
    for (int e = 0; e < 4; ++e) { const int col = tid + e * 256;
        v[e] = X1[(size_t)t * D + col] + mod[b * INW + 5120 + col] * (Y[(size_t)s0 * D + col] + Y[(size_t)s1 * D + col]); ss += v[e] * v[e]; }
    for (int o = 32; o > 0; o >>= 1) ss += __shfl_xor(ss, o);
    if ((tid & 63) == 0) red[tid >> 6] = ss;
    __syncthreads();
    const float rs = rsqrtf((red[0] + red[1] + red[2] + red[3]) / (float)D + EPS);
#pragma unroll
    for (int e = 0; e < 4; ++e) { const int col = tid + e * 256; out[(size_t)t * D + col] = v[e] * rs * fg[col]; }
}
}

extern "C" void kernel_launch(void* const* d_in, const int* in_sizes, int n_in, void* d_out, int out_size, void* d_ws, size_t ws_size, hipStream_t stream) {
    using namespace nv;
    if (ws_size < WS_END) { fprintf(stderr, "kernel_launch: workspace too small: %zu < %zu\n", ws_size, (size_t)WS_END); return; }
    const float* x = (const float*)d_in[0]; const float* c = (const float*)d_in[1]; const float* ctx = (const float*)d_in[2]; const float* c_ctx = (const float*)d_in[3];
    const float* ada_w = (const float*)d_in[4]; const float* ada_b = (const float*)d_in[5]; const float* g1 = (const float*)d_in[6]; const float* g2 = (const float*)d_in[7];
    const float* w_in = (const float*)d_in[8]; const float* hgrn_lb = (const float*)d_in[9]; const float* hgrn_ng = (const float*)d_in[10];
    const float* cw = (const float*)d_in[11]; const float* cb = (const float*)d_in[12];
    const float* fw1 = (const float*)d_in[13]; const float* fb1 = (const float*)d_in[14]; const float* ffr1 = (const float*)d_in[15];
    const float* fw2 = (const float*)d_in[16]; const float* fb2 = (const float*)d_in[17]; const float* ffr2 = (const float*)d_in[18]; const float* fw3 = (const float*)d_in[19];
    const float* hyd = (const float*)d_in[20]; const float* wpa = (const float*)d_in[21]; const float* wpb = (const float*)d_in[22]; const float* wo = (const float*)d_in[23];
    const float* rgw = (const float*)d_in[24]; const float* rgb = (const float*)d_in[25]; const float* rew = (const float*)d_in[26]; const float* reb = (const float*)d_in[27];
    const float* wgate = (const float*)d_in[28]; const float* wup = (const float*)d_in[29]; const float* wdown = (const float*)d_in[30]; const float* fng = (const float*)d_in[31];
    char* ws = (char*)d_ws; float* out = (float*)d_out;
    float* MOD = (float*)(ws + WS_MOD); float* LB = (float*)(ws + WS_LB); int* CNT = (int*)(ws + WS_CNT); int* TILEE = (int*)(ws + WS_TILEE);
    int* TOKE = (int*)(ws + WS_TOKE); float* TOKW = (float*)(ws + WS_TOKW); int* TOKS = (int*)(ws + WS_TOKS); int* SLOTT = (int*)(ws + WS_SLOTT); float* SLOTW = (float*)(ws + WS_SLOTW);
    bf16_t* P = (bf16_t*)(ws + WS_P);
    float* HX = (float*)(ws + WS_R1); float* U = (float*)(ws + WS_R1); float* YA = (float*)(ws + WS_R1); float* YB = (float*)(ws + WS_R1 + 32 * MiB);
    float* GN = (float*)(ws + WS_R2); float* O = (float*)(ws + WS_R2); bf16_t* MIXED = (bf16_t*)(ws + WS_R2);
    float* H2 = (float*)(ws + WS_P); float* HID = (float*)(ws + WS_P + 64 * MiB); float* Y = (float*)(ws + WS_P + 132 * MiB);

    (void)hipMemsetAsync(CNT, 0, 1024, stream);
    k_mod<<<dim3(INW / 256, 3), 256, 0, stream>>>(c, c_ctx, ada_w, ada_b, MOD);
    k_lb<<<4, 256, 0, stream>>>(hgrn_lb, LB);
    k_filter<<<L / 4, 256, 0, stream>>>(fw1, fb1, ffr1, fw2, fb2, ffr2, fw3, GN);
    k_prep<<<MR, 256, 0, stream>>>(x, ctx, g1, MOD, out, HX);
    { GemmArgs g{HX, nullptr, nullptr, w_in, nullptr, nullptr, 0, D, INW, D, 0}; k_gemm<float, 1, false, EpiStoreBf16><<<dim3(INW / 64, MR / 64), 256, 0, stream>>>(g, EpiStoreBf16{P, INW}); }
    k_hy_pre<<<T * 2, 256, 0, stream>>>(P, cw, cb, U);
    k_longconv<<<dim3(L / 64, 512 / 64, NB), 256, 0, stream>>>(U, GN, P, cw, cb, hyd, YB);
    k_gla<<<NB * NH * 2, 64, 0, stream>>>(P, LB, O, 0);
    k_gla<<<NB * NH * 2, 64, 0, stream>>>(P, LB, O, 1);
    k_readout<<<T, 512, 0, stream>>>(O, P, hgrn_ng, YA);
    { GemmArgs g{YA, YB, nullptr, wpa, wpb, nullptr, 0, 512, D, 512, 0}; k_gemm<float, 2, true, EpiMerge><<<dim3(D / 64, T / 64), 256, 0, stream>>>(g, EpiMerge{MIXED, P}); }
    { GemmArgs g{MIXED, nullptr, nullptr, wo, nullptr, nullptr, 0, D, D, D, 0}; k_gemm<bf16_t, 1, false, EpiX1><<<dim3(D / 64, T / 64), 256, 0, stream>>>(g, EpiX1{out, MOD}); }
    k_norm2_router<<<T, 256, 0, stream>>>(out, g2, MOD, rgw, rgb, rew, reb, H2, TOKE, TOKW, CNT);
    k_moe_offsets<<<1, 256, 0, stream>>>(CNT, TILEE, SLOTT);
    k_moe_scatter<<<T * 2 / 256, 256, 0, stream>>>(TOKE, TOKW, CNT, SLOTT, SLOTW, TOKS);
    { GemmArgs g{H2, nullptr, SLOTT, wgate, wup, TILEE, (size_t)D * DF, D, DF, D, 0}; k_gemm<float, 2, false, EpiHid><<<dim3(DF / 64, MAXSLOT / 64), 256, 0, stream>>>(g, EpiHid{HID, SLOTW}); }
    { GemmArgs g{HID, nullptr, nullptr, wdown, nullptr, TILEE, (size_t)DF * D, DF, D, DF, 0}; k_gemm<float, 1, false, EpiStoreF32><<<dim3(D / 64, MAXSLOT / 64), 256, 0, stream>>>(g, EpiStoreF32{Y, D}); }
    k_final<<<T, 256, 0, stream>>>(out, Y, TOKS, MOD, fng, out);
}
```

```cpp
#include <hip/hip_runtime.h>
#include <cstdio>
#include <cstdint>

namespace nv {
constexpr int NB = 2, L = 8192, D = 1024, T = NB * L, CTX = 256, TC = NB * CTX, MR = T + TC;
constexpr int INW = 6144, HK = 512, HV = 512, HYW = 512, NH = 4, DK = 128;
constexpr int C_Q = 0, C_ZF = 512, C_ZB = 1024, C_V = 1536, C_G = 2048, C_HY = 2560, C_GL = 4096;
constexpr int NG = 4, NE = 8, NEXP = 32, DF = 512;
constexpr int MAXSLOT = 34816;
constexpr float EPS = 1e-6f;
typedef unsigned short bf16_t;

__device__ __forceinline__ float bf2f(bf16_t v) { return __uint_as_float(((unsigned)v) << 16); }
__device__ __forceinline__ bf16_t f2bf(float f) { unsigned u = __float_as_uint(f); return (bf16_t)((u + 0x7fffu + ((u >> 16) & 1u)) >> 16); }
__device__ __forceinline__ float sigm(float x) { return 1.0f / (1.0f + expf(-x)); }
__device__ __forceinline__ float silu(float x) { return x * sigm(x); }

constexpr size_t MiB = 1u << 20;
constexpr size_t WS_MOD = 0;
constexpr size_t WS_LB = 128 * 1024;
constexpr size_t WS_CNT = 160 * 1024;
constexpr size_t WS_TILEE = 192 * 1024;
constexpr size_t WS_TOKE = 256 * 1024;
constexpr size_t WS_TOKW = 512 * 1024;
constexpr size_t WS_TOKS = 768 * 1024;
constexpr size_t WS_SLOTT = 1024 * 1024;
constexpr size_t WS_SLOTW = 1280 * 1024;
constexpr size_t WS_P = 4 * MiB;
constexpr size_t WS_R1 = 202 * MiB;
constexpr size_t WS_R2 = 268 * MiB;
constexpr size_t WS_END = 300 * MiB;

__global__ void k_mod(const float* c, const float* c_ctx, const float* ada_w, const float* ada_b, float* mod) {
    const int n = blockIdx.x * 256 + threadIdx.x, r = blockIdx.y;
    const float* cv = r < 2 ? c + r * D : c_ctx;
    float acc = 0.f;
    for (int k = 0; k < D; ++k) acc += silu(cv[k]) * ada_w[(size_t)k * INW + n];
    mod[r * INW + n] = acc + ada_b[n];
}
__global__ void k_lb(const float* hgrn_lb, float* lb) {
    const int i = blockIdx.x * 256 + threadIdx.x;
    const float p0 = hgrn_lb[i], p1 = hgrn_lb[1024 + i];
    lb[i] = 1.0f / (1.0f + expf(p1 - p0));
}
__global__ void k_filter(const float* w1, const float* b1, const float* fr1, const float* w2, const float* b2, const float* fr2, const float* w3, float* GN) {
    __shared__ float z[4][36], h1[4][64], h2[4][64];
    const int tid = threadIdx.x, pl = tid >> 6, j = tid & 63, i = blockIdx.x * 4 + pl;
    const float tl = (float)i / 8191.0f;
    if (j < 33) {
        float v;
        if (j == 0) v = tl;
        else {
            const int band = (j - 1) & 15;
            const float fb = 1e-4f + (float)band * ((15.0f - 1e-4f) / 15.0f);
            const float ang = (6.283185307179586f * (float)i / 8192.0f) * fb;
            v = (j <= 16) ? cosf(ang) : -sinf(ang);
        }
        z[pl][j] = v;
    }
    __syncthreads();
    { float a = b1[j]; for (int m = 0; m < 33; ++m) a += z[pl][m] * w1[m * 64 + j]; h1[pl][j] = sinf(fr1[j] * a); }
    __syncthreads();
    { float a = b2[j]; for (int m = 0; m < 64; ++m) a += h1[pl][m] * w2[m * 64 + j]; h2[pl][j] = sinf(fr2[j] * a); }
    __syncthreads();
    const float la = logf(0.01f) / 1.5f, lbb = logf(0.01f) / 0.3f;
    for (int o = 0; o < 16; ++o) {
        const int n = o * 64 + j;
        float a = 0.f; for (int m = 0; m < 64; ++m) a += h2[pl][m] * w3[m * 1024 + n];
        const int dir = n >> 9, c = n & 511;
        const float delta = fabsf(la + (float)c * ((lbb - la) / 511.0f));
        const float val = a * expf(-tl * delta);
        if (dir == 0) GN[(size_t)(8191 + i) * 512 + c] = val;
        else if (i >= 1) GN[(size_t)(8191 - i) * 512 + c] = val;
    }
}
__global__ void k_prep(const float* x, const float* ctx, const float* g1, const float* mod, float* xpos, float* hx) {
    __shared__ float red[4];
    const int row = blockIdx.x, tid = threadIdx.x;
    const bool isx = row < T;
    const float* src = isx ? x + (size_t)row * D : ctx + (size_t)(row - T) * D;
    const int mr = isx ? (row / L) : 2;
    float v[4]; float ss = 0.f;
#pragma unroll
    for (int e = 0; e < 4; ++e) {
        const int col = tid + e * 256;
        float val = src[col];
        if (isx) {
            const int t = row % L, rr = t / 64, cc = t % 64;
            const int quad = col >> 8, jj = col & 255;
            const float omega = expf(-(float)jj / 256.0f * 9.210340371976184f);
            const float pos = (quad < 2) ? (float)rr : (float)cc;
            const float a = pos * omega;
            val += (quad & 1) ? cosf(a) : sinf(a);
            xpos[(size_t)row * D + col] = val;
        }
        v[e] = val; ss += val * val;
    }
    for (int o = 32; o > 0; o >>= 1) ss += __shfl_xor(ss, o);
    if ((tid & 63) == 0) red[tid >> 6] = ss;
    __syncthreads();
    const float rs = rsqrtf((red[0] + red[1] + red[2] + red[3]) / (float)D + EPS);
#pragma unroll
    for (int e = 0; e < 4; ++e) {
        const int col = tid + e * 256;
        hx[(size_t)row * D + col] = v[e] * rs * g1[col] * (1.0f + mod[mr * INW + 1024 + col]) + mod[mr * INW + col];
    }
}

template <typename TA> __device__ __forceinline__ void load4(const TA* p, float (&o)[4]);
template <> __device__ __forceinline__ void load4<float>(const float* p, float (&o)[4]) { const float4 v = *(const float4*)p; o[0] = v.x; o[1] = v.y; o[2] = v.z; o[3] = v.w; }
template <> __device__ __forceinline__ void load4<bf16_t>(const bf16_t* p, float (&o)[4]) { const uint2 v = *(const uint2*)p; o[0] = __uint_as_float(v.x << 16); o[1] = __uint_as_float(v.x & 0xffff0000u); o[2] = __uint_as_float(v.y << 16); o[3] = __uint_as_float(v.y & 0xffff0000u); }

struct GemmArgs {
    const void* A; const void* A2; const int* rowidx;
    const float* B; const float* B2; const int* tile_expert; size_t bstride;
    int lda, ldb, K, pad;
};
template <typename TA, int NACC, bool DUALA, class Epi>
__global__ void __launch_bounds__(256) k_gemm(GemmArgs g, Epi epi) {
    __shared__ float As[NACC][16][68], Bs[NACC][16][68];
    const int tid = threadIdx.x, tx = tid & 15, ty = tid >> 4;
    const int row0 = blockIdx.y * 64, col0 = blockIdx.x * 64;
    if (g.tile_expert && g.tile_expert[blockIdx.y] < 0) return;
    const size_t boff = g.tile_expert ? (size_t)g.tile_expert[blockIdx.y] * g.bstride : 0;
    const int ar = tid >> 2, ak = (tid & 3) * 4;
    int arow = row0 + ar; if (g.rowidx) { arow = g.rowidx[arow]; if (arow < 0) arow = 0; }
    const TA* ap = (const TA*)g.A + (size_t)arow * g.lda + ak;
    const TA* ap2 = DUALA ? (const TA*)g.A2 + (size_t)arow * g.lda + ak : ap;
    const int bk = tid >> 4, bn = (tid & 15) * 4;
    const float* bp = g.B + boff + (size_t)bk * g.ldb + col0 + bn;
    const float* bp2 = NACC == 2 ? g.B2 + boff + (size_t)bk * g.ldb + col0 + bn : bp;
    float acc[NACC][4][4];
#pragma unroll
    for (int a = 0; a < NACC; ++a)
#pragma unroll
        for (int i = 0; i < 4; ++i)
#pragma unroll
            for (int j = 0; j < 4; ++j) acc[a][i][j] = 0.f;
    for (int k0 = 0; k0 < g.K; k0 += 16) {
        float av[4], av2[4]; load4<TA>(ap + k0, av); if (DUALA) load4<TA>(ap2 + k0, av2);
        const float4 bv = *(const float4*)(bp + (size_t)k0 * g.ldb);
        float4 bv2 = bv; if (NACC == 2) bv2 = *(const float4*)(bp2 + (size_t)k0 * g.ldb);
        __syncthreads();
#pragma unroll
        for (int e = 0; e < 4; ++e) { As[0][ak + e][ar] = av[e]; if (DUALA) As[NACC - 1][ak + e][ar] = av2[e]; }
        *(float4*)&Bs[0][bk][bn] = bv;
        if (NACC == 2) *(float4*)&Bs[NACC - 1][bk][bn] = bv2;
        __syncthreads();
#pragma unroll
        for (int kk = 0; kk < 16; ++kk) {
#pragma unroll
            for (int a = 0; a < NACC; ++a) {
                const float4 a4 = *(const float4*)&As[DUALA ? a : 0][kk][ty * 4];
                const float aa[4] = {a4.x, a4.y, a4.z, a4.w};
                const float4 b4 = *(const float4*)&Bs[a][kk][tx * 4];
                const float bb[4] = {b4.x, b4.y, b4.z, b4.w};
#pragma unroll
                for (int i = 0; i < 4; ++i)
#pragma unroll
                    for (int j = 0; j < 4; ++j) acc[a][i][j] += aa[i] * bb[j];
            }
        }
    }
#pragma unroll
    for (int i = 0; i < 4; ++i)
#pragma unroll
        for (int j = 0; j < 4; ++j) epi(row0 + ty * 4 + i, col0 + tx * 4 + j, acc[0][i][j], acc[NACC - 1][i][j]);
}
struct EpiStoreBf16 { bf16_t* C; long ldc; __device__ void operator()(int r, int c, float a, float) const { C[(size_t)r * ldc + c] = f2bf(a); } };
struct EpiStoreF32 { float* C; long ldc; __device__ void operator()(int r, int c, float a, float) const { C[(size_t)r * ldc + c] = a; } };
struct EpiMerge { bf16_t* MX; const bf16_t* P; __device__ void operator()(int r, int c, float a, float b) const {
    MX[(size_t)r * D + c] = f2bf(sigm(bf2f(P[(size_t)r * INW + C_GL + c])) * a + sigm(bf2f(P[(size_t)r * INW + C_GL + 1024 + c])) * b); } };
struct EpiX1 { float* X; const float* mod; __device__ void operator()(int r, int c, float a, float) const { const int b = r / L; X[(size_t)r * D + c] += mod[b * INW + 2048 + c] * a; } };
struct EpiHid { float* H; const float* slot_w; __device__ void operator()(int r, int c, float g, float u) const { H[(size_t)r * DF + c] = silu(g) * u * slot_w[r]; } };

__global__ void __launch_bounds__(64) k_gla(const bf16_t* P, const float* lb, float* O, int dir) {
    __shared__ float sf[4][128], sk[4][128], sq[4][128];
    const int lane = threadIdx.x, vh = blockIdx.x & 1, h = (blockIdx.x >> 1) & 3, b = blockIdx.x >> 3;
    const int v = vh * 64 + lane;
    float S[128];
#pragma unroll
    for (int k = 0; k < 128; ++k) S[k] = 0.f;
    const float lb0 = lb[dir * 512 + h * 128 + lane], lb1 = lb[dir * 512 + h * 128 + 64 + lane];
    const int zc = (dir == 0 ? C_ZF : C_ZB) + h * 128;
    for (int ph = 0; ph < 2; ++ph) {
        const int n = ph == 0 ? CTX : L;
        const size_t rbase = ph == 0 ? (size_t)(T + b * CTX) : (size_t)b * L;
        for (int g0 = 0; g0 < n; g0 += 4) {
            float vv[4];
#pragma unroll
            for (int j = 0; j < 4; ++j) {
                const int tt = dir == 0 ? (g0 + j) : (n - 1 - g0 - j);
                const bf16_t* pr = P + (rbase + tt) * INW;
                const float z0 = bf2f(pr[zc + lane]), z1 = bf2f(pr[zc + 64 + lane]);
                sf[j][lane] = lb0 + (1.f - lb0) * sigm(z0); sf[j][64 + lane] = lb1 + (1.f - lb1) * sigm(z1);
                sk[j][lane] = (1.f - lb0) * sigm(-z0); sk[j][64 + lane] = (1.f - lb1) * sigm(-z1);
                sq[j][lane] = bf2f(pr[C_Q + h * 128 + lane]); sq[j][64 + lane] = bf2f(pr[C_Q + h * 128 + 64 + lane]);
                vv[j] = bf2f(pr[C_V + h * 128 + v]);
            }
            __syncthreads();
#pragma unroll
            for (int j = 0; j < 4; ++j) {
                float o = 0.f;
#pragma unroll
                for (int k = 0; k < 128; k += 4) {
                    const float4 f4 = *(const float4*)&sf[j][k], k4 = *(const float4*)&sk[j][k], q4 = *(const float4*)&sq[j][k];
                    S[k] = f4.x * S[k] + k4.x * vv[j]; o += S[k] * q4.x;
                    S[k + 1] = f4.y * S[k + 1] + k4.y * vv[j]; o += S[k + 1] * q4.y;
                    S[k + 2] = f4.z * S[k + 2] + k4.z * vv[j]; o += S[k + 2] * q4.z;
                    S[k + 3] = f4.w * S[k + 3] + k4.w * vv[j]; o += S[k + 3] * q4.w;
                }
                if (ph == 1) {
                    const int tt = dir == 0 ? (g0 + j) : (n - 1 - g0 - j);
                    float* op = O + (rbase + tt) * HV + h * 128 + v;
                    if (dir == 0) *op = o; else *op += o;
                }
            }
            __syncthreads();
        }
    }
}
template <typename TO> __device__ __forceinline__ void stv(TO* p, float v);
template <> __device__ __forceinline__ void stv<float>(float* p, float v) { *p = v; }
template <> __device__ __forceinline__ void stv<bf16_t>(bf16_t* p, float v) { *p = f2bf(v); }
template <typename TO>
__global__ void __launch_bounds__(512) k_readout(const float* O, const float* O2, const bf16_t* P, const float* ng, TO* YA, int ldy) {
    __shared__ float red[8];
    const int t = blockIdx.x, c = threadIdx.x, h = c >> 7;
    const float o = O[(size_t)t * HV + c] + (O2 ? O2[(size_t)t * HV + c] : 0.f);
    float ss = o * o;
    for (int m = 32; m > 0; m >>= 1) ss += __shfl_xor(ss, m);
    if ((c & 63) == 0) red[c >> 6] = ss;
    __syncthreads();
    const float rs = rsqrtf((red[2 * h] + red[2 * h + 1]) / 128.0f + EPS);
    const float g = bf2f(P[(size_t)t * INW + C_G + c]);
    stv<TO>(YA + (size_t)t * ldy + c, o * rs * ng[c & 127] * silu(g));
}
__device__ __forceinline__ float conv3(const bf16_t* P, int b, int t, int ch, const float* cw, const float* cb) {
    const size_t r = (size_t)b * L + t;
    float a = cb[ch] + bf2f(P[r * INW + C_HY + ch]) * cw[1536 + ch];
    if (t > 0) a += bf2f(P[(r - 1) * INW + C_HY + ch]) * cw[ch];
    if (t < L - 1) a += bf2f(P[(r + 1) * INW + C_HY + ch]) * cw[2 * 1536 + ch];
    return a;
}
__global__ void k_hy_pre(const bf16_t* P, const float* cw, const float* cb, float* U) {
    const int c = threadIdx.x + (blockIdx.x & 1) * 256, r = blockIdx.x >> 1, b = r / L, t = r % L;
    U[(size_t)r * 512 + c] = conv3(P, b, t, c, cw, cb) * conv3(P, b, t, 512 + c, cw, cb);
}
template <typename TO>
__global__ void __launch_bounds__(256) k_longconv(const float* U, const float* GN, const bf16_t* P, const float* cw, const float* cb, const float* hyd, TO* YB, int ldy) {
    const int tid = threadIdx.x, c = blockIdx.y * 64 + (tid & 63), tg = tid >> 6, b = blockIdx.z;
    const int tbase = blockIdx.x * 64 + tg * 16;
    float acc[16], ep[16], en[16];
#pragma unroll
    for (int i = 0; i < 16; ++i) acc[i] = 0.f;
    const float* ub = U + (size_t)b * L * 512 + c;
    const float* gb = GN + c;
#pragma unroll
    for (int m = 0; m < 16; ++m) ep[m] = gb[(size_t)(8191 + tbase + m) * 512];
    for (int s0 = 0; s0 < L; s0 += 16) {
        const int base = 8191 + tbase - s0;
#pragma unroll
        for (int n = 1; n < 16; ++n) en[n] = gb[(size_t)(base - n) * 512];
        float uv[16];
#pragma unroll
        for (int j = 0; j < 16; ++j) uv[j] = ub[(size_t)(s0 + j) * 512];
#pragma unroll
        for (int j = 0; j < 16; ++j)
#pragma unroll
            for (int i = 0; i < 16; ++i) { const int m = i - j; acc[i] += (m >= 0 ? ep[m] : en[-m]) * uv[j]; }
        if (s0 + 16 < L) {
#pragma unroll
            for (int m = 1; m < 16; ++m) ep[m] = en[16 - m];
            ep[0] = gb[(size_t)(base - 16) * 512];
        }
    }
#pragma unroll
    for (int i = 0; i < 16; ++i) {
        const int t = tbase + i; const size_t r = (size_t)b * L + t;
        const float y = acc[i] + hyd[c] * U[r * 512 + c];
        stv<TO>(YB + r * ldy + c, conv3(P, b, t, 1024 + c, cw, cb) * y);
    }
}
__global__ void __launch_bounds__(256) k_norm2_router(const float* X1, const float* g2, const float* mod, const float* wg, const float* bg, const float* we, const float* be,
                                                     float* H2, int* tok_e, float* tok_w, int* cnt) {
    __shared__ float red[4], part[4][8], lg[8];
    __shared__ int gsel;
    const int t = blockIdx.x, tid = threadIdx.x, b = t / L;
    float v[4], hh[4]; float ss = 0.f;
#pragma unroll
    for (int e = 0; e < 4; ++e) { v[e] = X1[(size_t)t * D + tid + e * 256]; ss += v[e] * v[e]; }
    for (int o = 32; o > 0; o >>= 1) ss += __shfl_xor(ss, o);
    if ((tid & 63) == 0) red[tid >> 6] = ss;
    __syncthreads();
    const float rs = rsqrtf((red[0] + red[1] + red[2] + red[3]) / (float)D + EPS);
#pragma unroll
    for (int e = 0; e < 4; ++e) { const int col = tid + e * 256; hh[e] = v[e] * rs * g2[col] * (1.0f + mod[b * INW + 4096 + col]) + mod[b * INW + 3072 + col]; H2[(size_t)t * D + col] = hh[e]; }
    float pg[4];
#pragma unroll
    for (int gq = 0; gq < 4; ++gq) { float a = 0.f;
#pragma unroll
        for (int e = 0; e < 4; ++e) a += hh[e] * wg[(tid + e * 256) * 4 + gq];
        for (int o = 32; o > 0; o >>= 1) a += __shfl_xor(a, o);
        pg[gq] = a; }
    if ((tid & 63) == 0) { for (int gq = 0; gq < 4; ++gq) part[tid >> 6][gq] = pg[gq]; }
    __syncthreads();
    if (tid == 0) {
        float l[4]; for (int gq = 0; gq < 4; ++gq) l[gq] = part[0][gq] + part[1][gq] + part[2][gq] + part[3][gq] + bg[gq];
        int bi = 0; for (int gq = 1; gq < 4; ++gq) if (l[gq] > l[bi]) bi = gq;
        float den = 0.f; for (int gq = 0; gq < 4; ++gq) den += expf(l[gq] - l[bi]);
        lg[0] = 1.0f / den; gsel = bi;
    }
    __syncthreads();
    const int gi = gsel; const float ptop = lg[0];
    __syncthreads();
    float pe[8];
#pragma unroll
    for (int q = 0; q < 8; ++q) { float a = 0.f;
#pragma unroll
        for (int e = 0; e < 4; ++e) a += hh[e] * we[((size_t)gi * D + tid + e * 256) * 8 + q];
        for (int o = 32; o > 0; o >>= 1) a += __shfl_xor(a, o);
        pe[q] = a; }
    if ((tid & 63) == 0) { for (int q = 0; q < 8; ++q) part[tid >> 6][q] = pe[q]; }
    __syncthreads();
    if (tid == 0) {
        float l[8]; for (int q = 0; q < 8; ++q) l[q] = part[0][q] + part[1][q] + part[2][q] + part[3][q] + be[gi * 8 + q];
        int i1 = 0; for (int q = 1; q < 8; ++q) if (l[q] > l[i1]) i1 = q;
        int i2 = -1; for (int q = 0; q < 8; ++q) if (q != i1 && (i2 < 0 || l[q] > l[i2])) i2 = q;
        const float e2 = expf(l[i2] - l[i1]);
        const int ea = gi * 8 + i1, eb = gi * 8 + i2;
        tok_e[t * 2] = ea; tok_e[t * 2 + 1] = eb;
        tok_w[t * 2] = ptop / (1.0f + e2); tok_w[t * 2 + 1] = ptop * e2 / (1.0f + e2);
        atomicAdd(&cnt[ea], 1); atomicAdd(&cnt[eb], 1);
    }
}
__global__ void k_moe_offsets(int* cnt, int* tile_expert, int* slot_tok) {
    if (threadIdx.x == 0) {
        int off = 0;
        for (int e = 0; e < NEXP; ++e) { cnt[64 + e] = off; const int nt = (cnt[e] + 63) / 64; for (int i = 0; i < nt; ++i) tile_expert[off / 64 + i] = e; off += nt * 64; }
        cnt[64 + NEXP] = off;
        for (int i = off / 64; i < MAXSLOT / 64; ++i) tile_expert[i] = -1;
    }
    __syncthreads();
    for (int i = threadIdx.x; i < MAXSLOT; i += blockDim.x) slot_tok[i] = -1;
}
__global__ void k_moe_scatter(const int* tok_e, const float* tok_w, int* cnt, int* slot_tok, float* slot_w, int* tok_slot) {
    const int i = blockIdx.x * 256 + threadIdx.x;
    const int e = tok_e[i];
    const int s = cnt[64 + e] + atomicAdd(&cnt[32 + e], 1);
    slot_tok[s] = i >> 1; slot_w[s] = tok_w[i]; tok_slot[i] = s;
}
__global__ void __launch_bounds__(256) k_final(const float* X1, const float* Y, const int* tok_slot, const float* mod, const float* fg, float* out) {
    __shared__ float red[4];
    const int t = blockIdx.x, tid = threadIdx.x, b = t / L;
    const int s0 = tok_slot[t * 2], s1 = tok_slot[t * 2 + 1];
    float v[4]; float ss = 0.f;
#pragma unroll
    for (int e = 0; e < 4; ++e) { const int col = tid + e * 256;
        v[e] = X1[(size_t)t * D + col] + mod[b * INW + 5120 + col] * (Y[(size_t)s0 * D + col] + Y[(size_t)s1 * D + col]); ss += v[e] * v[e]; }
    for (int o = 32; o > 0; o >>= 1) ss += __shfl_xor(ss, o);
    if ((tid & 63) == 0) red[tid >> 6] = ss;
    __syncthreads();
    const float rs = rsqrtf((red[0] + red[1] + red[2] + red[3]) / (float)D + EPS);
#pragma unroll
    for (int e = 0; e < 4; ++e) { const int col = tid + e * 256; out[(size_t)t * D + col] = v[e] * rs * fg[col]; }
}
}


namespace nv {
static void tail_from_P(void* const* d_in, void* d_out, void* d_ws, hipStream_t stream) {
    const float* g2 = (const float*)d_in[7]; const float* hgrn_ng = (const float*)d_in[10];
    const float* cw = (const float*)d_in[11]; const float* cb = (const float*)d_in[12];
    const float* fw1 = (const float*)d_in[13]; const float* fb1 = (const float*)d_in[14]; const float* ffr1 = (const float*)d_in[15];
    const float* fw2 = (const float*)d_in[16]; const float* fb2 = (const float*)d_in[17]; const float* ffr2 = (const float*)d_in[18]; const float* fw3 = (const float*)d_in[19];
    const float* hyd = (const float*)d_in[20]; const float* wpa = (const float*)d_in[21]; const float* wpb = (const float*)d_in[22]; const float* wo = (const float*)d_in[23];
    const float* rgw = (const float*)d_in[24]; const float* rgb = (const float*)d_in[25]; const float* rew = (const float*)d_in[26]; const float* reb = (const float*)d_in[27];
    const float* wgate = (const float*)d_in[28]; const float* wup = (const float*)d_in[29]; const float* wdown = (const float*)d_in[30]; const float* fng = (const float*)d_in[31];
    char* ws = (char*)d_ws; float* out = (float*)d_out;
    float* MOD = (float*)(ws + 1 * MiB); float* LB = (float*)(ws + 1 * MiB + 96 * 1024);
    bf16_t* P = (bf16_t*)(ws + 18 * MiB);
    float* GN = (float*)(ws + 216 * MiB); float* O = GN; bf16_t* MIXED = (bf16_t*)GN;
    float* U = (float*)(ws + 248 * MiB); float* YA = U; float* YB = (float*)(ws + 280 * MiB);
    int* CNT = (int*)(ws + 2 * MiB); int* TILEE = (int*)(ws + 2 * MiB + 64 * 1024); int* TOKE = (int*)(ws + 3 * MiB); float* TOKW = (float*)(ws + 4 * MiB); int* TOKS = (int*)(ws + 5 * MiB);
    int* SLOTT = (int*)(ws + 6 * MiB); float* SLOTW = (float*)(ws + 7 * MiB);
    float* H2 = (float*)(ws + 18 * MiB); float* HID = (float*)(ws + 82 * MiB); float* Y = (float*)(ws + 150 * MiB);
    k_filter<<<L / 4, 256, 0, stream>>>(fw1, fb1, ffr1, fw2, fb2, ffr2, fw3, GN);
    k_hy_pre<<<T * 2, 256, 0, stream>>>(P, cw, cb, U);
    k_longconv<float><<<dim3(L / 64, 512 / 64, NB), 256, 0, stream>>>(U, GN, P, cw, cb, hyd, YB, 512);
    k_gla<<<NB * NH * 2, 64, 0, stream>>>(P, LB, O, 0);
    k_gla<<<NB * NH * 2, 64, 0, stream>>>(P, LB, O, 1);
    k_readout<float><<<T, 512, 0, stream>>>(O, nullptr, P, hgrn_ng, YA, 512);
    { GemmArgs g{YA, YB, nullptr, wpa, wpb, nullptr, 0, 512, D, 512, 0}; k_gemm<float, 2, true, EpiMerge><<<dim3(D / 64, T / 64), 256, 0, stream>>>(g, EpiMerge{MIXED, P}); }
    { GemmArgs g{MIXED, nullptr, nullptr, wo, nullptr, nullptr, 0, D, D, D, 0}; k_gemm<bf16_t, 1, false, EpiX1><<<dim3(D / 64, T / 64), 256, 0, stream>>>(g, EpiX1{out, MOD}); }
    (void)hipMemsetAsync(CNT, 0, 1024, stream);
    k_norm2_router<<<T, 256, 0, stream>>>(out, g2, MOD, rgw, rgb, rew, reb, H2, TOKE, TOKW, CNT);
    k_moe_offsets<<<1, 256, 0, stream>>>(CNT, TILEE, SLOTT);
    k_moe_scatter<<<T * 2 / 256, 256, 0, stream>>>(TOKE, TOKW, CNT, SLOTT, SLOTW, TOKS);
    { GemmArgs g{H2, nullptr, SLOTT, wgate, wup, TILEE, (size_t)D * DF, D, DF, D, 0}; k_gemm<float, 2, false, EpiHid><<<dim3(DF / 64, MAXSLOT / 64), 256, 0, stream>>>(g, EpiHid{HID, SLOTW}); }
    { GemmArgs g{HID, nullptr, nullptr, wdown, nullptr, TILEE, (size_t)DF * D, DF, D, DF, 0}; k_gemm<float, 1, false, EpiStoreF32><<<dim3(D / 64, MAXSLOT / 64), 256, 0, stream>>>(g, EpiStoreF32{Y, D}); }
    k_final<<<T, 256, 0, stream>>>(out, Y, TOKS, MOD, fng, out);
}
}

namespace nv {
static void tail_from_O(void* const* d_in, void* d_out, void* d_ws, hipStream_t stream, const float* Of, const float* Ob, bool have_yb) {
    const float* g2 = (const float*)d_in[7]; const float* hgrn_ng = (const float*)d_in[10];
    const float* cw = (const float*)d_in[11]; const float* cb = (const float*)d_in[12];
    const float* fw1 = (const float*)d_in[13]; const float* fb1 = (const float*)d_in[14]; const float* ffr1 = (const float*)d_in[15];
    const float* fw2 = (const float*)d_in[16]; const float* fb2 = (const float*)d_in[17]; const float* ffr2 = (const float*)d_in[18]; const float* fw3 = (const float*)d_in[19];
    const float* hyd = (const float*)d_in[20]; const float* wpa = (const float*)d_in[21]; const float* wpb = (const float*)d_in[22]; const float* wo = (const float*)d_in[23];
    const float* rgw = (const float*)d_in[24]; const float* rgb = (const float*)d_in[25]; const float* rew = (const float*)d_in[26]; const float* reb = (const float*)d_in[27];
    const float* wgate = (const float*)d_in[28]; const float* wup = (const float*)d_in[29]; const float* wdown = (const float*)d_in[30]; const float* fng = (const float*)d_in[31];
    char* ws = (char*)d_ws; float* out = (float*)d_out;
    float* MOD = (float*)(ws + 1 * MiB);
    bf16_t* P = (bf16_t*)(ws + 18 * MiB);
    bf16_t* YA = (bf16_t*)(ws + 2 * MiB); bf16_t* YB = (bf16_t*)(ws + 216 * MiB);
    float* GN = (float*)(ws + 248 * MiB); float* U = (float*)(ws + 280 * MiB); bf16_t* MIXED = (bf16_t*)(ws + 248 * MiB);
    k_readout<bf16_t><<<T, 512, 0, stream>>>(Of, Ob, P, hgrn_ng, YA, 512);
    if (!have_yb) {
        k_filter<<<L / 4, 256, 0, stream>>>(fw1, fb1, ffr1, fw2, fb2, ffr2, fw3, GN);
        k_hy_pre<<<T * 2, 256, 0, stream>>>(P, cw, cb, U);
        k_longconv<bf16_t><<<dim3(L / 64, 512 / 64, NB), 256, 0, stream>>>(U, GN, P, cw, cb, hyd, YB, 512);
    }
    { GemmArgs g{YA, YB, nullptr, wpa, wpb, nullptr, 0, 512, D, 512, 0}; k_gemm<bf16_t, 2, true, EpiMerge><<<dim3(D / 64, T / 64), 256, 0, stream>>>(g, EpiMerge{MIXED, P}); }
    { GemmArgs g{MIXED, nullptr, nullptr, wo, nullptr, nullptr, 0, D, D, D, 0}; k_gemm<bf16_t, 1, false, EpiX1><<<dim3(D / 64, T / 64), 256, 0, stream>>>(g, EpiX1{out, MOD}); }
    int* CNT = (int*)(ws + 250 * MiB); int* TILEE = (int*)(ws + 250 * MiB + 64 * 1024); int* TOKE = (int*)(ws + 251 * MiB); float* TOKW = (float*)(ws + 252 * MiB); int* TOKS = (int*)(ws + 253 * MiB);
    int* SLOTT = (int*)(ws + 254 * MiB); float* SLOTW = (float*)(ws + 255 * MiB);
    float* H2 = (float*)(ws + 18 * MiB); float* HID = (float*)(ws + 82 * MiB); float* Y = (float*)(ws + 256 * MiB);
    H2 = (float*)(ws + 2 * MiB); HID = (float*)(ws + 66 * MiB); Y = (float*)(ws + 134 * MiB); CNT = (int*)(ws + 272 * MiB); TILEE = (int*)(ws + 272 * MiB + 64 * 1024);
    TOKE = (int*)(ws + 273 * MiB); TOKW = (float*)(ws + 274 * MiB); TOKS = (int*)(ws + 275 * MiB); SLOTT = (int*)(ws + 276 * MiB); SLOTW = (float*)(ws + 277 * MiB);
    (void)hipMemsetAsync(CNT, 0, 1024, stream);
    k_norm2_router<<<T, 256, 0, stream>>>(out, g2, MOD, rgw, rgb, rew, reb, H2, TOKE, TOKW, CNT);
    k_moe_offsets<<<1, 256, 0, stream>>>(CNT, TILEE, SLOTT);
    k_moe_scatter<<<T * 2 / 256, 256, 0, stream>>>(TOKE, TOKW, CNT, SLOTT, SLOTW, TOKS);
    { GemmArgs g{H2, nullptr, SLOTT, wgate, wup, TILEE, (size_t)D * DF, D, DF, D, 0}; k_gemm<float, 2, false, EpiHid><<<dim3(DF / 64, MAXSLOT / 64), 256, 0, stream>>>(g, EpiHid{HID, SLOTW}); }
    { GemmArgs g{HID, nullptr, nullptr, wdown, nullptr, TILEE, (size_t)DF * D, DF, D, DF, 0}; k_gemm<float, 1, false, EpiStoreF32><<<dim3(D / 64, MAXSLOT / 64), 256, 0, stream>>>(g, EpiStoreF32{Y, D}); }
    k_final<<<T, 256, 0, stream>>>(out, Y, TOKS, MOD, fng, out);
}
}

namespace nv {
__global__ void k_xpos(const float* x, float* xpos) {
    const int row = blockIdx.x, tid = threadIdx.x, t = row % L, rr = t / 64, cc = t % 64;
    for (int e = 0; e < 4; ++e) { const int col = tid + e * 256, quad = col >> 8, jj = col & 255;
        const float omega = expf(-(float)jj / 256.0f * 9.210340371976184f), a = ((quad < 2) ? (float)rr : (float)cc) * omega;
        xpos[(size_t)row * D + col] = x[(size_t)row * D + col] + ((quad & 1) ? cosf(a) : sinf(a)); }
}
static void tail_from_YAB(void* const* d_in, void* d_out, void* d_ws, hipStream_t stream) {
    const float* g2 = (const float*)d_in[7];
    const float* wpa = (const float*)d_in[21]; const float* wpb = (const float*)d_in[22]; const float* wo = (const float*)d_in[23];
    const float* rgw = (const float*)d_in[24]; const float* rgb = (const float*)d_in[25]; const float* rew = (const float*)d_in[26]; const float* reb = (const float*)d_in[27];
    const float* wgate = (const float*)d_in[28]; const float* wup = (const float*)d_in[29]; const float* wdown = (const float*)d_in[30]; const float* fng = (const float*)d_in[31];
    char* ws = (char*)d_ws; float* out = (float*)d_out;
    float* MOD = (float*)(ws + 1 * MiB);
    bf16_t* P = (bf16_t*)(ws + 18 * MiB); bf16_t* YAB = (bf16_t*)(ws + 216 * MiB); bf16_t* MIXED = (bf16_t*)(ws + 248 * MiB);
    k_xpos<<<T, 256, 0, stream>>>((const float*)d_in[0], out);
    { GemmArgs g{YAB, YAB + 512, nullptr, wpa, wpb, nullptr, 0, 1024, D, 512, 0}; k_gemm<bf16_t, 2, true, EpiMerge><<<dim3(D / 64, T / 64), 256, 0, stream>>>(g, EpiMerge{MIXED, P}); }
    { GemmArgs g{MIXED, nullptr, nullptr, wo, nullptr, nullptr, 0, D, D, D, 0}; k_gemm<bf16_t, 1, false, EpiX1><<<dim3(D / 64, T / 64), 256, 0, stream>>>(g, EpiX1{out, MOD}); }
    float* H2 = (float*)(ws + 2 * MiB); float* HID = (float*)(ws + 66 * MiB); float* Y = (float*)(ws + 134 * MiB); int* CNT = (int*)(ws + 272 * MiB); int* TILEE = (int*)(ws + 272 * MiB + 64 * 1024);
    int* TOKE = (int*)(ws + 273 * MiB); float* TOKW = (float*)(ws + 274 * MiB); int* TOKS = (int*)(ws + 275 * MiB); int* SLOTT = (int*)(ws + 276 * MiB); float* SLOTW = (float*)(ws + 277 * MiB);
    (void)hipMemsetAsync(CNT, 0, 1024, stream);
    k_norm2_router<<<T, 256, 0, stream>>>(out, g2, MOD, rgw, rgb, rew, reb, H2, TOKE, TOKW, CNT);
    k_moe_offsets<<<1, 256, 0, stream>>>(CNT, TILEE, SLOTT);
    k_moe_scatter<<<T * 2 / 256, 256, 0, stream>>>(TOKE, TOKW, CNT, SLOTT, SLOTW, TOKS);
    { GemmArgs g{H2, nullptr, SLOTT, wgate, wup, TILEE, (size_t)D * DF, D, DF, D, 0}; k_gemm<float, 2, false, EpiHid><<<dim3(DF / 64, MAXSLOT / 64), 256, 0, stream>>>(g, EpiHid{HID, SLOTW}); }
    { GemmArgs g{HID, nullptr, nullptr, wdown, nullptr, TILEE, (size_t)DF * D, DF, D, DF, 0}; k_gemm<float, 1, false, EpiStoreF32><<<dim3(D / 64, MAXSLOT / 64), 256, 0, stream>>>(g, EpiStoreF32{Y, D}); }
    k_final<<<T, 256, 0, stream>>>(out, Y, TOKS, MOD, fng, out);
}
}

namespace pg8 {
#define PG8_LAS __attribute__((address_space(3)))
typedef unsigned short bf16_t;
typedef short bf16x8 __attribute__((ext_vector_type(8)));
typedef float f32x4 __attribute__((ext_vector_type(4)));
typedef unsigned u32x4 __attribute__((ext_vector_type(4)));
constexpr int BM = 256, BK = 64, HALF = 128, HTB = HALF * BK * 2  , STAGE_BYTES = 8 * HTB, NXCD = 8, WGM = 8;

__host__ __device__ __forceinline__ int lds_byte(int r, int c) { const int st = (r >> 4) * 2 + (c >> 5), rr = r & 15, cc = c & 31, ob = rr * 64 + cc * 2; return st * 1024 + (ob ^ (((ob >> 9) & 1) << 5)); }
__host__ __device__ __forceinline__ void stage_rc(int b, int& R, int& C) { const int st = b / 1024, sb = b % 1024, swz = sb ^ (((sb >> 9) & 1) << 5); R = (st >> 1) * 16 + swz / 64; C = (st & 1) * 32 + (swz % 64) / 2; }
__host__ __device__ __forceinline__ int perm32(int rho) { const int n = rho >> 4, i = rho & 15; return 8 * (i >> 2) + 4 * n + (i & 3); }

struct Unit { int pm, pn; };
struct Gemm { const bf16_t* A; const bf16_t* Bt; int M, N, K; };

struct StaticOrder {
    int nM, nN, nwg, G, c;
    __host__ __device__ void init(int M, int N, int G_, int c_) { nM = M / BM; nN = N / BM; nwg = nM * nN; G = G_; c = c_; }
    __host__ __device__ bool next(int i, Unit& u) const {
        const long L = (long)i * G + c; if (L >= nwg) return false;
        int wgid = (int)L; { const int q = nwg / NXCD, r = nwg % NXCD, xcd = wgid % NXCD, off = wgid / NXCD; wgid = (xcd < r ? xcd * (q + 1) : r * (q + 1) + (xcd - r) * q) + off; }
        const int nig = WGM * nN, gid = wgid / nig, fm = gid * WGM, gsz = (nM - fm) < WGM ? (nM - fm) : WGM;
        u.pm = fm + ((wgid % nig) % gsz); u.pn = (wgid % nig) / gsz; return true;
    }
    __device__ __forceinline__ void a_ready(const Unit&) const {}
    __device__ __forceinline__ void done(const Unit&) const {}
};


__device__ __forceinline__ unsigned cvt_pk_bf16(float lo, float hi) { unsigned r; asm volatile("v_cvt_pk_bf16_f32 %0, %1, %2" : "=v"(r) : "v"(lo), "v"(hi)); return r; }
__device__ __forceinline__ float fsigm(float x) { return __builtin_amdgcn_rcpf(1.0f + __expf(-x)); }
__device__ __forceinline__ float bflo(unsigned w) { return __uint_as_float(w << 16); }
__device__ __forceinline__ float bfhi(unsigned w) { return __uint_as_float(w & 0xffff0000u); }

struct EpiBf16Store {
    static constexpr bool PERM = true, AFTER_DRAIN = false, MIDK = false;
    bf16_t* O; long ldc;
    __device__ __forceinline__ void operator()(const f32x4 (&acc)[2][2][4][2], const Unit& u, int wr, int wc, int fr, int fq) const {
        const int row0 = u.pm * BM + wr * 64 + fr, col0 = u.pn * BM + wc * 32 + 8 * fq;
#pragma unroll
        for (int ai = 0; ai < 2; ++ai)
#pragma unroll
            for (int m = 0; m < 4; ++m) { bf16_t* rowp = O + (size_t)(row0 + ai * HALF + m * 16) * ldc + col0;
#pragma unroll
                for (int bj = 0; bj < 2; ++bj) { const f32x4 v0 = acc[ai][bj][m][0], v1 = acc[ai][bj][m][1];
                    u32x4 w; w.x = cvt_pk_bf16(v0[0], v0[1]); w.y = cvt_pk_bf16(v0[2], v0[3]); w.z = cvt_pk_bf16(v1[0], v1[1]); w.w = cvt_pk_bf16(v1[2], v1[3]);
                    *(u32x4*)(rowp + bj * HALF) = w; } }
    }
};

struct EpiGate1 {
    static constexpr bool PERM = true, AFTER_DRAIN = false, MIDK = false;
    float* T1; const bf16_t* Pg;
    __device__ __forceinline__ void operator()(const f32x4 (&acc)[2][2][4][2], const Unit& u, int wr, int wc, int fr, int fq) const {
        const int row0 = u.pm * BM + wr * 64 + fr, col0 = u.pn * BM + wc * 32 + 8 * fq;
#pragma unroll
        for (int ai = 0; ai < 2; ++ai)
#pragma unroll
            for (int m = 0; m < 4; ++m) { const size_t row = (size_t)(row0 + ai * HALF + m * 16); const bf16_t* gp = Pg + row * 6144 + col0;
#pragma unroll
                for (int bj = 0; bj < 2; ++bj) { const u32x4 ga = *(const u32x4*)(gp + bj * HALF); const unsigned gw[4] = {ga.x, ga.y, ga.z, ga.w};
                    const f32x4 v0 = acc[ai][bj][m][0], v1 = acc[ai][bj][m][1];
                    f32x4 o0, o1;
                    o0[0] = v0[0] * fsigm(bflo(gw[0])); o0[1] = v0[1] * fsigm(bfhi(gw[0])); o0[2] = v0[2] * fsigm(bflo(gw[1])); o0[3] = v0[3] * fsigm(bfhi(gw[1]));
                    o1[0] = v1[0] * fsigm(bflo(gw[2])); o1[1] = v1[1] * fsigm(bfhi(gw[2])); o1[2] = v1[2] * fsigm(bflo(gw[3])); o1[3] = v1[3] * fsigm(bfhi(gw[3]));
                    float* tp = T1 + row * 1024 + col0 + bj * HALF; *(f32x4*)tp = o0; *(f32x4*)(tp + 4) = o1; } }
    }
};
struct EpiGate2 {
    static constexpr bool PERM = true, AFTER_DRAIN = false, MIDK = false;
    const float* T1; bf16_t* O; const bf16_t* Pg;
    __device__ __forceinline__ void operator()(const f32x4 (&acc)[2][2][4][2], const Unit& u, int wr, int wc, int fr, int fq) const {
        const int row0 = u.pm * BM + wr * 64 + fr, col0 = u.pn * BM + wc * 32 + 8 * fq;
#pragma unroll
        for (int ai = 0; ai < 2; ++ai)
#pragma unroll
            for (int m = 0; m < 4; ++m) { const size_t row = (size_t)(row0 + ai * HALF + m * 16); const bf16_t* gp = Pg + row * 6144 + col0 + 1024;
#pragma unroll
                for (int bj = 0; bj < 2; ++bj) { const u32x4 gb = *(const u32x4*)(gp + bj * HALF); const unsigned gw[4] = {gb.x, gb.y, gb.z, gb.w};
                    const float* tp = T1 + row * 1024 + col0 + bj * HALF; const f32x4 t0 = *(const f32x4*)tp, t1 = *(const f32x4*)(tp + 4);
                    const f32x4 v0 = acc[ai][bj][m][0], v1 = acc[ai][bj][m][1];
                    u32x4 w; w.x = cvt_pk_bf16(t0[0] + v0[0] * fsigm(bflo(gw[0])), t0[1] + v0[1] * fsigm(bfhi(gw[0]))); w.y = cvt_pk_bf16(t0[2] + v0[2] * fsigm(bflo(gw[1])), t0[3] + v0[3] * fsigm(bfhi(gw[1])));
                    w.z = cvt_pk_bf16(t1[0] + v1[0] * fsigm(bflo(gw[2])), t1[1] + v1[1] * fsigm(bfhi(gw[2]))); w.w = cvt_pk_bf16(t1[2] + v1[2] * fsigm(bflo(gw[3])), t1[3] + v1[3] * fsigm(bfhi(gw[3])));
                    *(u32x4*)(O + row * 1024 + col0 + bj * HALF) = w; } }
    }
};
struct EpiX1 {
    static constexpr bool PERM = false, AFTER_DRAIN = false, MIDK = false;
    const float* X; float* O; const float* gt1; const float* PER; const float* PEC;
    __device__ __forceinline__ void operator()(const f32x4 (&acc)[2][2][4][2], const Unit& u, int wr, int wc, int fr, int fq) const {
        const int row0 = u.pm * BM + wr * 64 + fr, col0 = u.pn * BM + wc * 32 + 4 * fq;
#pragma unroll
        for (int ai = 0; ai < 2; ++ai)
#pragma unroll
            for (int m = 0; m < 4; ++m) { const int row = row0 + ai * HALF + m * 16, b = row >> 13, t = row & 8191;
#pragma unroll
                for (int bj = 0; bj < 2; ++bj)
#pragma unroll
                    for (int n = 0; n < 2; ++n) { const int col = col0 + bj * HALF + n * 16;
                        const f32x4 xv = *(const f32x4*)(X + (size_t)row * 1024 + col), gv = *(const f32x4*)(gt1 + b * 6144 + col);
                        const f32x4 pe = col < 512 ? *(const f32x4*)(PER + (size_t)(t >> 6) * 512 + col) : *(const f32x4*)(PEC + (size_t)(t & 63) * 512 + col - 512);
                        *(f32x4*)(O + (size_t)row * 1024 + col) = xv + pe + gv * acc[ai][bj][m][n]; } }
    }
};
struct EpiHid {
    static constexpr bool PERM = true, AFTER_DRAIN = false, MIDK = false;
    bf16_t* H; const float* slot_w;
    __device__ __forceinline__ void operator()(const f32x4 (&acc)[2][2][4][2], const Unit& u, int wr, int wc, int fr, int fq) const {
        const int row0 = u.pm * BM + wr * 64 + fr, col0 = (u.pn & 3) * HALF + wc * 32 + 8 * fq;
#pragma unroll
        for (int ai = 0; ai < 2; ++ai)
#pragma unroll
            for (int m = 0; m < 4; ++m) { const size_t row = (size_t)(row0 + ai * HALF + m * 16); const float ws = slot_w[row];
                float h[8];
#pragma unroll
                for (int q = 0; q < 8; ++q) { const float g = acc[ai][0][m][q >> 2][q & 3], uu = acc[ai][1][m][q >> 2][q & 3]; h[q] = g * fsigm(g) * uu * ws; }
                u32x4 w; w.x = cvt_pk_bf16(h[0], h[1]); w.y = cvt_pk_bf16(h[2], h[3]); w.z = cvt_pk_bf16(h[4], h[5]); w.w = cvt_pk_bf16(h[6], h[7]);
                *(u32x4*)(H + row * 512 + col0) = w; }
    }
};
struct EpiY {
    static constexpr bool PERM = true, AFTER_DRAIN = false, MIDK = false;
    bf16_t* O;
    __device__ __forceinline__ void operator()(const f32x4 (&acc)[2][2][4][2], const Unit& u, int wr, int wc, int fr, int fq) const {
        const int row0 = u.pm * BM + wr * 64 + fr, col0 = (u.pn & 3) * BM + wc * 32 + 8 * fq;
#pragma unroll
        for (int ai = 0; ai < 2; ++ai)
#pragma unroll
            for (int m = 0; m < 4; ++m) { bf16_t* rowp = O + (size_t)(row0 + ai * HALF + m * 16) * 1024 + col0;
#pragma unroll
                for (int bj = 0; bj < 2; ++bj) { const f32x4 v0 = acc[ai][bj][m][0], v1 = acc[ai][bj][m][1];
                    u32x4 w; w.x = cvt_pk_bf16(v0[0], v0[1]); w.y = cvt_pk_bf16(v0[2], v0[3]); w.z = cvt_pk_bf16(v1[0], v1[1]); w.w = cvt_pk_bf16(v1[2], v1[3]);
                    *(u32x4*)(rowp + bj * HALF) = w; } }
    }
};
struct MoeOrder {
    const int* tile_e; int ntiles, G, c;
    __device__ bool next(int i, Unit& u) const { const int Lx = i * G + c; if (Lx >= ntiles * 4) return false; u.pm = Lx >> 2; u.pn = tile_e[u.pm] * 4 + (Lx & 3); return true; }
    __device__ __forceinline__ void a_ready(const Unit&) const {}
    __device__ __forceinline__ void done(const Unit&) const {}
};

template <class Epi, class Sched, bool ALIGN_EPI = false, bool SP2 = false>
__device__ __forceinline__ void gemm_phase(PG8_LAS unsigned char* lds, const Gemm g, const Sched& S, const Epi& E) {
    const int tid = threadIdx.x, wid = __builtin_amdgcn_readfirstlane(tid >> 6), lane = tid & 63, wr = wid >> 2, wc = wid & 3, fr = lane & 15, fq = lane >> 4;
    const int K = g.K, nt = K / BK;
    unsigned voffA[2], voffB[2];
#pragma unroll
    for (int i = 0; i < 2; ++i) { int R, C; stage_rc(tid * 16 + i * 8192, R, C); const int Rb = Epi::PERM ? ((R & ~31) + perm32(R & 31)) : R;
        voffA[i] = (unsigned)(R * K + C) * 2u; voffB[i] = (unsigned)(Rb * K + C) * 2u; }
    const size_t kstep = (size_t)(BK * 2);
    const size_t hstep = (size_t)HALF * K * 2;
    const size_t tstep = 2 * hstep;
    const unsigned ldsw = (unsigned)wid * 1024u;
    const int aoff = lds_byte(wr * 64 + fr, fq * 8), boff = lds_byte(wc * 32 + fr, fq * 8);
#define PG8_SA(b, h) (((b) * 2 + (h)) * HTB)
#define PG8_SB(b, h) ((4 + (b) * 2 + (h)) * HTB)
#define PG8_STAGE(bufoff, gbase, voff) do { _Pragma("unroll") for (int _i = 0; _i < 2; ++_i) \
        __builtin_amdgcn_global_load_lds((const unsigned*)((const char*)(gbase) + (voff)[_i]), (PG8_LAS unsigned*)(lds + (bufoff) + ldsw + _i * 8192), 16, 0, 0); } while (0)
#define PG8_LDA(dst, b, h) do { _Pragma("unroll") for (int m = 0; m < 4; ++m) _Pragma("unroll") for (int k = 0; k < 2; ++k) dst[m][k] = *(const PG8_LAS bf16x8*)(lds + PG8_SA(b, h) + aoff + m * 2048 + k * 1024); } while (0)
#define PG8_LDB(dst, b, h) do { _Pragma("unroll") for (int n = 0; n < 2; ++n) _Pragma("unroll") for (int k = 0; k < 2; ++k) dst[n][k] = *(const PG8_LAS bf16x8*)(lds + PG8_SB(b, h) + boff + n * 2048 + k * 1024); } while (0)
#define PG8_MMA(ai, bj, At, Bt) do { __builtin_amdgcn_s_setprio(1); _Pragma("unroll") for (int m = 0; m < 4; ++m) _Pragma("unroll") for (int n = 0; n < 2; ++n) _Pragma("unroll") for (int k = 0; k < 2; ++k) \
        acc[ai][bj][m][n] = __builtin_amdgcn_mfma_f32_16x16x32_bf16(Bt[n][k], At[m][k], acc[ai][bj][m][n], 0, 0, 0); __builtin_amdgcn_s_setprio(0); } while (0)
#define PG8_WAIT_V(n) asm volatile("s_waitcnt vmcnt(" #n ")" ::: "memory")
#define PG8_WAIT_L(n) asm volatile("s_waitcnt lgkmcnt(" #n ")" ::: "memory")
#define PG8_BAR __builtin_amdgcn_s_barrier()
#define PG8_SCHED __builtin_amdgcn_sched_barrier(0)
    Unit cur, nxt; int ui = 0;
    if (!S.next(0, cur)) return;
    f32x4 acc[2][2][4][2];
#pragma unroll
    for (int a = 0; a < 2; ++a)
#pragma unroll
        for (int b = 0; b < 2; ++b)
#pragma unroll
            for (int m = 0; m < 4; ++m)
#pragma unroll
                for (int n = 0; n < 2; ++n) acc[a][b][m][n] = (f32x4){0.f, 0.f, 0.f, 0.f};
    bf16x8 At[4][2], B0[2][2], B1[2][2];
    const char* cA = (const char*)g.A + (size_t)cur.pm * tstep; const char* cB = (const char*)g.Bt + (size_t)cur.pn * tstep;
    S.a_ready(cur);
    if constexpr (SP2) {
        PG8_STAGE(PG8_SB(0, 0), cB, voffB); PG8_STAGE(PG8_SB(0, 1), cB + hstep, voffB); PG8_STAGE(PG8_SA(0, 0), cA, voffA); PG8_STAGE(PG8_SA(0, 1), cA + hstep, voffA);
        if (wr == 1) PG8_BAR;
        PG8_WAIT_V(2); PG8_BAR;
        PG8_STAGE(PG8_SB(1, 0), cB + kstep, voffB); PG8_STAGE(PG8_SA(1, 0), cA + kstep, voffA); PG8_STAGE(PG8_SB(1, 1), cB + hstep + kstep, voffB);
        PG8_WAIT_V(6); PG8_BAR;
    } else {
        PG8_STAGE(PG8_SB(0, 0), cB, voffB); PG8_STAGE(PG8_SA(0, 0), cA, voffA); PG8_STAGE(PG8_SB(0, 1), cB + hstep, voffB); PG8_STAGE(PG8_SA(0, 1), cA + hstep, voffA);
        if (wr == 1) PG8_BAR;
        PG8_WAIT_V(4); PG8_BAR;
        PG8_STAGE(PG8_SB(1, 0), cB + kstep, voffB); PG8_STAGE(PG8_SA(1, 0), cA + kstep, voffA); PG8_STAGE(PG8_SB(1, 1), cB + hstep + kstep, voffB);
        PG8_WAIT_V(6); PG8_BAR;
    }
    for (;;) {
        const bool has_next = S.next(ui + 1, nxt);
        const char* nA = has_next ? (const char*)g.A + (size_t)nxt.pm * tstep : cA; const char* nB = has_next ? (const char*)g.Bt + (size_t)nxt.pn * tstep : cB;
        for (int t = 0; t < nt; t += 2) {
            const bool last = (t == nt - 2);
            const char* a1 = cA + (size_t)(t + 1) * kstep;
            const char* a2 = last ? nA : cA + (size_t)(t + 2) * kstep; const char* b2 = last ? nB : cB + (size_t)(t + 2) * kstep;
            const char* a3 = a2 + kstep; const char* b3 = b2 + kstep;
            if (last && has_next) S.a_ready(nxt);
            if constexpr (SP2) {
            PG8_LDB(B0, 0, 0); PG8_LDB(B1, 0, 1); PG8_SCHED; PG8_LDA(At, 0, 0); PG8_STAGE(PG8_SA(1, 1), a1 + hstep, voffA);
            PG8_WAIT_V(8); PG8_WAIT_L(0); PG8_BAR; PG8_MMA(0, 0, At, B0); PG8_MMA(0, 1, At, B1); PG8_BAR; PG8_SCHED;
            PG8_LDA(At, 0, 1); PG8_STAGE(PG8_SB(0, 0), b2, voffB); PG8_STAGE(PG8_SB(0, 1), b2 + hstep, voffB); PG8_STAGE(PG8_SA(0, 0), a2, voffA);
            PG8_WAIT_V(8); PG8_WAIT_L(0); PG8_BAR; PG8_MMA(1, 0, At, B0); PG8_MMA(1, 1, At, B1); PG8_BAR; PG8_SCHED;
            PG8_LDB(B0, 1, 0); PG8_LDB(B1, 1, 1); PG8_SCHED; PG8_LDA(At, 1, 0); PG8_STAGE(PG8_SA(0, 1), a2 + hstep, voffA);
            PG8_WAIT_V(8); PG8_WAIT_L(0); PG8_BAR; PG8_MMA(0, 0, At, B0); PG8_MMA(0, 1, At, B1); PG8_BAR; PG8_SCHED;
            PG8_LDA(At, 1, 1); PG8_STAGE(PG8_SB(1, 0), b3, voffB); PG8_STAGE(PG8_SB(1, 1), b3 + hstep, voffB); PG8_STAGE(PG8_SA(1, 0), a3, voffA);
            PG8_WAIT_V(8); PG8_WAIT_L(0); PG8_BAR; PG8_MMA(1, 0, At, B0); PG8_MMA(1, 1, At, B1); PG8_BAR; PG8_SCHED;
            } else {
            PG8_LDB(B0, 0, 0); PG8_SCHED; PG8_LDA(At, 0, 0); PG8_STAGE(PG8_SA(1, 1), a1 + hstep, voffA);
            PG8_WAIT_L(8); PG8_BAR; PG8_WAIT_L(0); PG8_MMA(0, 0, At, B0); PG8_BAR; PG8_SCHED;
            PG8_LDB(B1, 0, 1); PG8_STAGE(PG8_SB(0, 0), b2, voffB);
            PG8_BAR; PG8_WAIT_L(0); PG8_MMA(0, 1, At, B1); PG8_BAR;
            PG8_LDA(At, 0, 1); PG8_STAGE(PG8_SA(0, 0), a2, voffA);
            PG8_BAR; PG8_WAIT_L(0); PG8_MMA(1, 0, At, B0); PG8_BAR; PG8_SCHED;
            PG8_STAGE(PG8_SB(0, 1), b2 + hstep, voffB);
            PG8_WAIT_V(6); PG8_BAR; PG8_MMA(1, 1, At, B1); PG8_BAR;
            PG8_LDB(B0, 1, 0); PG8_SCHED; PG8_LDA(At, 1, 0); PG8_STAGE(PG8_SA(0, 1), a2 + hstep, voffA);
            PG8_WAIT_L(8); PG8_BAR; PG8_WAIT_L(0); PG8_MMA(0, 0, At, B0); PG8_BAR; PG8_SCHED;
            PG8_LDB(B1, 1, 1); PG8_STAGE(PG8_SB(1, 0), b3, voffB);
            PG8_BAR; PG8_WAIT_L(0); PG8_MMA(0, 1, At, B1); PG8_BAR;
            PG8_LDA(At, 1, 1); PG8_STAGE(PG8_SA(1, 0), a3, voffA);
            PG8_BAR; PG8_WAIT_L(0); PG8_MMA(1, 0, At, B0); PG8_BAR; PG8_SCHED;
            PG8_STAGE(PG8_SB(1, 1), b3 + hstep, voffB);
            PG8_WAIT_V(6); PG8_BAR; PG8_MMA(1, 1, At, B1); PG8_BAR;
            }
        }
        if constexpr (ALIGN_EPI) { if (wr == 0) PG8_BAR; }
        if constexpr (!Epi::AFTER_DRAIN) { E(acc, cur, wr, wc, fr, fq); S.done(cur); }
        if (!has_next) break;
#pragma unroll
        for (int a = 0; a < 2; ++a)
#pragma unroll
            for (int b = 0; b < 2; ++b)
#pragma unroll
                for (int m = 0; m < 4; ++m)
#pragma unroll
                    for (int n = 0; n < 2; ++n) acc[a][b][m][n] = (f32x4){0.f, 0.f, 0.f, 0.f};
        cur = nxt; cA = nA; cB = nB; ++ui;
        if constexpr (ALIGN_EPI) { if (wr == 1) PG8_BAR; }
    }
    PG8_WAIT_V(0);
    if constexpr (!ALIGN_EPI) { if (wr == 0) PG8_BAR; }
    PG8_BAR;
    if constexpr (Epi::AFTER_DRAIN) { E.fused(acc, cur, wr, wc, fr, fq, lds, wid, lane); S.done(cur); }
#undef PG8_SA
#undef PG8_SB
#undef PG8_STAGE
#undef PG8_LDA
#undef PG8_LDB
#undef PG8_MMA
#undef PG8_WAIT_V
#undef PG8_WAIT_L
#undef PG8_BAR
#undef PG8_SCHED
}
}

#define GAS __attribute__((address_space(1)))
#define LAS __attribute__((address_space(3)))
typedef unsigned short bf16;
typedef unsigned v4u __attribute__((ext_vector_type(4)));
typedef float f32x4 __attribute__((ext_vector_type(4)));
typedef short bf16x8 __attribute__((ext_vector_type(8)));
typedef GAS unsigned gu32;
typedef GAS unsigned long long gu64;
#define RLX_AGENT __ATOMIC_RELAXED, __HIP_MEMORY_SCOPE_AGENT
#define LDS_WAIT() asm volatile("s_waitcnt lgkmcnt(0)" ::: "memory")
#define VM_WAIT() asm volatile("s_waitcnt vmcnt(0)" ::: "memory")
__device__ __forceinline__ unsigned long long rt() { return __builtin_amdgcn_s_memrealtime(); }
__device__ __forceinline__ unsigned f2bf(float f) { unsigned u = __builtin_bit_cast(unsigned, f); return (u + 0x7fffu + ((u >> 16) & 1u)) >> 16; }
__device__ __forceinline__ unsigned pk2(float lo, float hi) { return f2bf(lo) | (f2bf(hi) << 16); }

#define XB_TMO      128
#define XB_XCNT(j)  (256  + 64 * (j))
#define XB_XSUB(j)  (1280 + 64 * (j))
#define XB_XGEN(j)  (2304 + 64 * (j))
#define XB_TOP      3328
#define XB_TOPGEN   3392
#define XCD_BAR_WORDS 3456
#define XB_SPIN_CAP (1u << 18)

__device__ __forceinline__ unsigned xb_ld(unsigned* p)              { return __hip_atomic_load(p, __ATOMIC_RELAXED, __HIP_MEMORY_SCOPE_AGENT); }
__device__ __forceinline__ unsigned xb_add(unsigned* p, unsigned v) { return __hip_atomic_fetch_add(p, v, __ATOMIC_RELAXED, __HIP_MEMORY_SCOPE_AGENT); }
__device__ __forceinline__ unsigned xb_xcc_id() { return (unsigned)__builtin_amdgcn_s_getreg((3 << 11) | 20) & 0xFu; }
#define XB_SPIN(cond, bar) do { unsigned _sp = 0; while (cond) { __builtin_amdgcn_s_sleep(1); \
    if ((++_sp & 255u) == 0u) { if (xb_ld(&(bar)[XB_TMO])) break; if (_sp > XB_SPIN_CAP) { atomicAdd(&(bar)[XB_TMO], 1u); break; } } } } while (0)

struct XcdBarrier {
    unsigned* bar; unsigned x;
    volatile LAS unsigned* st;
};

__device__ __forceinline__ XcdBarrier xcd_barrier_post(unsigned* bar, volatile LAS unsigned* st) {
    XcdBarrier b; b.bar = bar; b.x = xb_xcc_id(); b.st = st;
    if (threadIdx.x == 0) (void)xb_add(&bar[XB_XCNT(b.x)], 1u);
    return b;
}
__device__ __forceinline__ void xcd_barrier_complete(unsigned* bar, unsigned x, unsigned& nloc, unsigned& nx) {
    const unsigned G = gridDim.x * gridDim.y * gridDim.z;
    unsigned sum, cnt, mine, sp = 0u;
    for (;;) {
        sum = 0u; cnt = 0u; mine = 0u;
#pragma unroll
        for (unsigned j = 0; j < 16; ++j) { const unsigned c = xb_ld(&bar[XB_XCNT(j)]); sum += c; cnt += (c > 0u) ? 1u : 0u; mine = (j == x) ? c : mine; }
        if (sum == G) break;
        __builtin_amdgcn_s_sleep(1);
        if ((++sp & 255u) == 0u) { if (xb_ld(&bar[XB_TMO])) break; if (sp > XB_SPIN_CAP) { atomicAdd(&bar[XB_TMO], 1u); break; } }
    }
    nloc = mine > 0u ? mine : 1u; nx = cnt > 0u ? cnt : 1u;
}

__device__ __forceinline__ void xcd_barrier(const XcdBarrier& b) {
    asm volatile("s_waitcnt vmcnt(0)" ::: "memory");
    __syncthreads();
    if (threadIdx.x == 0) {
        unsigned* bar = b.bar;
        __builtin_amdgcn_s_waitcnt(0);
        unsigned nloc = b.st[0], nx = b.st[1];
        if (nloc == 0u) { xcd_barrier_complete(bar, b.x, nloc, nx); b.st[0] = nloc; b.st[1] = nx; }
        const unsigned old = xb_add(&bar[XB_XSUB(b.x)], 1u);
        const unsigned gen = old / nloc;
        if (old + 1u == (gen + 1u) * nloc) {
            __builtin_amdgcn_fence(__ATOMIC_RELEASE, "agent");
            asm volatile("s_waitcnt vmcnt(0)" ::: "memory");
            const unsigned og = xb_add(&bar[XB_TOP], 1u);
            const unsigned tg = og / nx;
            if (og + 1u == (tg + 1u) * nx) xb_add(&bar[XB_TOPGEN], 1u);
            else XB_SPIN(xb_ld(&bar[XB_TOPGEN]) == tg, bar);
            __builtin_amdgcn_fence(__ATOMIC_ACQUIRE, "agent");
            xb_add(&bar[XB_XGEN(b.x)], 1u);
            asm volatile("s_waitcnt vmcnt(0)" ::: "memory");
        } else {
            XB_SPIN(xb_ld(&bar[XB_XGEN(b.x)]) == gen, bar);
            __builtin_amdgcn_fence(__ATOMIC_ACQUIRE, "agent");
            asm volatile("s_waitcnt vmcnt(0)" ::: "memory");
        }
    }
    __syncthreads();
}

namespace mk {
using pg8::bf16_t;
constexpr int NWAVES = 8, NTHR = 512;
constexpr int NB = 2, L = 8192, D = 1024, T = NB * L, CTX = 256, TC = NB * CTX, MR = T + TC;
constexpr int INW = 6144;
constexpr int C_Q = 0, C_ZF = 512, C_ZB = 1024, C_V = 1536, C_G = 2048, C_HY = 2560, C_GL = 4096;
constexpr float EPS = 1e-6f;
constexpr size_t MiB = 1u << 20;
constexpr size_t WS_CTL = 0, CTL_ZERO_BYTES = 64 * 1024;
constexpr size_t WS_MOD = 1 * MiB;
constexpr size_t WS_LB = 1 * MiB + 96 * 1024;
constexpr size_t WS_PER = 1 * MiB + 128 * 1024;
constexpr size_t WS_PEC = 1 * MiB + 384 * 1024;
constexpr size_t WS_WIN_T = 2 * MiB;
constexpr size_t WS_WA_T = 14 * MiB, WS_WB_T = 15 * MiB;
constexpr size_t WS_WO_T = 16 * MiB;
constexpr size_t WS_P = 18 * MiB;
constexpr size_t WS_HX = 216 * MiB;
constexpr size_t WS_GR = 249 * MiB;
constexpr size_t WS_UT = 265 * MiB;
constexpr size_t WS_YT = 281 * MiB;
constexpr size_t WS_END = 300 * MiB;
constexpr int CW_BAR = 1024;
constexpr int LDS_BYTES = 163840, MISC_OFF = LDS_BYTES - 256;

struct Args { const float* in[32]; float* out; unsigned char* ws; int ph_lo, ph_hi; };

__device__ __forceinline__ float bf2f_(bf16_t v) { return __uint_as_float(((unsigned)v) << 16); }
__device__ __forceinline__ float sigm(float x) { return 1.0f / (1.0f + __expf(-x)); }
__device__ __forceinline__ float silu(float x) { return x * sigm(x); }
__device__ __forceinline__ float wave_sum(float v) {
#pragma unroll
    for (int o = 1; o < 64; o <<= 1) v += __shfl_xor(v, o);
    return v;
}

struct Frame {
    LAS unsigned char* lds;
    int tid, lane, wave, vcu, G, gw, NGW;
    const float* const* in; float* out; unsigned char* ws;
};

__device__ __forceinline__ void p0_transpose_item(const float* W, int N, bf16_t* WT, int ldk, int koff, LAS float* scr, int item, int lane) {
    const int nblk = N / 32, kb = item / nblk, nb = item % nblk, k0 = 64 * kb, n0 = 32 * nb;
#pragma unroll 8
    for (int i = 0; i < 32; ++i) { const int kk = 2 * i + (lane >> 5); scr[kk * 33 + (lane & 31)] = W[(size_t)(k0 + kk) * N + n0 + (lane & 31)]; }
    LDS_WAIT(); asm volatile("" ::: "memory");
    const int c = lane & 7;
#pragma unroll
    for (int j = 0; j < 4; ++j) { const int n = (lane >> 3) + 8 * j; const LAS float* s = scr + (8 * c) * 33 + n;
        v4u o; o.x = pk2(s[0 * 33], s[1 * 33]); o.y = pk2(s[2 * 33], s[3 * 33]); o.z = pk2(s[4 * 33], s[5 * 33]); o.w = pk2(s[6 * 33], s[7 * 33]);
        *(GAS v4u*)(WT + (size_t)(n0 + n) * ldk + koff + k0 + 8 * c) = o; }
    LDS_WAIT(); asm volatile("" ::: "memory");
}
__device__ __forceinline__ void p0_filter_item(Frame& F, int item) {
    const float* w1 = F.in[13]; const float* b1 = F.in[14]; const float* fr1 = F.in[15]; const float* w2 = F.in[16]; const float* b2 = F.in[17]; const float* fr2 = F.in[18];
    const float* w3 = F.in[19]; const float* hyd = F.in[20];
    bf16_t* GR = (bf16_t*)(F.ws + WS_GR);
    LAS float* zs = (LAS float*)F.lds;
    LAS float* h1s = zs + 33 * 36;
    LAS float* h2s = h1s + 33 * 64;
    const int i0 = item * 32, tid = F.tid;
    for (int e = tid; e < 33 * 33; e += NTHR) {
        const int p = e / 33, j = e % 33, i = i0 + p;
        float v;
        if (j == 0) v = (float)i / 8191.0f;
        else { const int band = (j - 1) & 15; const float fb = 1e-4f + (float)band * ((15.0f - 1e-4f) / 15.0f);
               const float ang = (6.283185307179586f * (float)i / 8192.0f) * fb; v = (j <= 16) ? cosf(ang) : -sinf(ang); }
        zs[p * 36 + j] = v;
    }
    __syncthreads();
    for (int e = tid; e < 33 * 64; e += NTHR) { const int p = e >> 6, j = e & 63; float a = b1[j];
        for (int m = 0; m < 33; ++m) a += zs[p * 36 + m] * w1[m * 64 + j];
        h1s[p * 64 + j] = sinf(fr1[j] * a); }
    __syncthreads();
    for (int e = tid; e < 33 * 64; e += NTHR) { const int p = e >> 6, j = e & 63; float a = b2[j];
        for (int m = 0; m < 64; ++m) a += h1s[p * 64 + m] * w2[m * 64 + j];
        h2s[j * 36 + p] = sinf(fr2[j] * a); }
    __syncthreads();
    float af[33], ab[33];
#pragma unroll
    for (int p = 0; p < 33; ++p) { af[p] = 0.f; ab[p] = 0.f; }
    for (int m = 0; m < 64; ++m) {
        const float wa = w3[m * 1024 + tid], wb = w3[m * 1024 + 512 + tid];
#pragma unroll
        for (int p4 = 0; p4 < 32; p4 += 4) { const f32x4 h = *(const LAS f32x4*)(h2s + m * 36 + p4);
#pragma unroll
            for (int q = 0; q < 4; ++q) { af[p4 + q] += h[q] * wa; ab[p4 + q] += h[q] * wb; } }
        const float hl = h2s[m * 36 + 32]; af[32] += hl * wa; ab[32] += hl * wb;
    }
    const float la = __logf(0.01f) / 1.5f, lbb = __logf(0.01f) / 0.3f;
    const float delta = fabsf(la + (float)tid * ((lbb - la) / 511.0f));
    const float dsk = hyd[tid];
    {
        unsigned w[16];
#pragma unroll
        for (int e = 0; e < 32; e += 2) {
            const int p0 = 31 - e, p1 = 30 - e;
            float v0 = af[p0] * __expf(-((float)(i0 + p0) / 8191.0f) * delta), v1 = af[p1] * __expf(-((float)(i0 + p1) / 8191.0f) * delta);
            if (i0 + p0 == 0) v0 += dsk; if (i0 + p1 == 0) v1 += dsk;
            w[e >> 1] = pk2(v0, v1);
        }
        GAS v4u* dst = (GAS v4u*)(GR + (size_t)tid * 16384 + 8160 - i0);
#pragma unroll
        for (int q = 0; q < 4; ++q) { v4u o; o.x = w[4 * q]; o.y = w[4 * q + 1]; o.z = w[4 * q + 2]; o.w = w[4 * q + 3]; dst[q] = o; }
    }
    {
        unsigned w[16];
#pragma unroll
        for (int e = 0; e < 32; e += 2) {
            const int p0 = e + 1, p1 = e + 2;
            float v0 = ab[p0] * __expf(-((float)(i0 + p0) / 8191.0f) * delta), v1 = ab[p1] * __expf(-((float)(i0 + p1) / 8191.0f) * delta);
            if (i0 + p0 >= L) v0 = 0.f; if (i0 + p1 >= L) v1 = 0.f;
            w[e >> 1] = pk2(v0, v1);
        }
        GAS v4u* dst = (GAS v4u*)(GR + (size_t)tid * 16384 + 8192 + i0);
#pragma unroll
        for (int q = 0; q < 4; ++q) { v4u o; o.x = w[4 * q]; o.y = w[4 * q + 1]; o.z = w[4 * q + 2]; o.w = w[4 * q + 3]; dst[q] = o; }
    }
    __syncthreads();
}
__device__ __forceinline__ void p0_prologue(Frame& F) {
    for (int it = F.vcu; it < L / 32; it += F.G) p0_filter_item(F, it);
    __syncthreads();
    LAS float* scr = (LAS float*)(F.lds + F.wave * 16384);
    const float* c = F.in[1]; const float* c_ctx = F.in[3]; const float* ada_w = F.in[4]; const float* ada_b = F.in[5];
    float* MOD = (float*)(F.ws + WS_MOD); float* LBo = (float*)(F.ws + WS_LB); float* PER = (float*)(F.ws + WS_PER); float* PEC = (float*)(F.ws + WS_PEC);
    constexpr int I_MOD = 96, I_LB = 16, I_PE = 24 * 8, I_WIN = 16 * 192, I_WP = 8 * 32, I_WO = 16 * 32;
    constexpr int NITEMS = I_MOD + I_LB + I_PE + I_WIN + 2 * I_WP + I_WO;
    const int lane = F.lane;
    for (int it = F.gw; it < NITEMS; it += F.NGW) {
        int r = it;
        if (r < I_MOD) {
            const int n = r * 64 + lane; float a0 = 0.f, a1 = 0.f, a2 = 0.f;
            for (int k0 = 0; k0 < D; k0 += 64) {
                const float s0 = silu(c[k0 + lane]), s1 = silu(c[D + k0 + lane]), s2 = silu(c_ctx[k0 + lane]);
#pragma unroll 16
                for (int kk = 0; kk < 64; ++kk) { const float w = ada_w[(size_t)(k0 + kk) * INW + n];
                    a0 += __shfl(s0, kk) * w; a1 += __shfl(s1, kk) * w; a2 += __shfl(s2, kk) * w; }
            }
            const float bb = ada_b[n]; MOD[n] = a0 + bb; MOD[INW + n] = a1 + bb; MOD[2 * INW + n] = a2 + bb; continue;
        } r -= I_MOD;
        if (r < I_LB) { const int i = r * 64 + lane; const float* hl = F.in[9]; LBo[i] = 1.0f / (1.0f + __expf(hl[1024 + i] - hl[i])); continue; } r -= I_LB;
        if (r < I_PE) {
            const int pos = r < 128 ? r : r - 128; float* dst = r < 128 ? PER + (size_t)r * 512 : PEC + (size_t)(r - 128) * 512;
#pragma unroll
            for (int e = 0; e < 8; ++e) { const int col = e * 64 + lane, jj = col & 255;
                const float omega = expf(-(float)jj / 256.0f * 9.210340371976184f), a = (float)pos * omega;
                dst[col] = (col >> 8) ? cosf(a) : sinf(a); }
            continue;
        } r -= I_PE;
        if (r < I_WIN) { p0_transpose_item(F.in[8], INW, (bf16_t*)(F.ws + WS_WIN_T), D, 0, scr, r, lane); continue; } r -= I_WIN;
        if (r < I_WP) { p0_transpose_item(F.in[21], D, (bf16_t*)(F.ws + WS_WA_T), 512, 0, scr, r, lane); continue; } r -= I_WP;
        if (r < I_WP) { p0_transpose_item(F.in[22], D, (bf16_t*)(F.ws + WS_WB_T), 512, 0, scr, r, lane); continue; } r -= I_WP;
        p0_transpose_item(F.in[23], D, (bf16_t*)(F.ws + WS_WO_T), D, 0, scr, r, lane);
    }
}
template <bool WRITE_XPOS>
__device__ __forceinline__ void p1_prep(Frame& F) {
    const float* x = F.in[0]; const float* ctx = F.in[2]; const float* g1 = F.in[6];
    const float* MOD = (const float*)(F.ws + WS_MOD); const float* PER = (const float*)(F.ws + WS_PER); const float* PEC = (const float*)(F.ws + WS_PEC);
    bf16_t* HX = (bf16_t*)(F.ws + WS_HX);
    const int lane = F.lane;
    for (int row = F.gw; row < MR; row += F.NGW) {
        const bool isx = row < T;
        const float* src = isx ? x + (size_t)row * D : ctx + (size_t)(row - T) * D;
        const int mr = isx ? (row >> 13) : 2, t = row & (L - 1);
        f32x4 v[4]; float ss = 0.f;
#pragma unroll
        for (int j = 0; j < 4; ++j) {
            const int col = 4 * lane + 256 * j;
            v[j] = *(const GAS f32x4*)(src + col);
            if (isx) { const f32x4 pe = (j < 2) ? *(const GAS f32x4*)(PER + (size_t)(t >> 6) * 512 + col) : *(const GAS f32x4*)(PEC + (size_t)(t & 63) * 512 + col - 512); v[j] = v[j] + pe;
                       if (WRITE_XPOS) *(GAS f32x4*)(F.out + (size_t)row * D + col) = v[j]; }
            ss += (v[j].x * v[j].x + v[j].y * v[j].y) + (v[j].z * v[j].z + v[j].w * v[j].w);
        }
        const float rs = rsqrtf(wave_sum(ss) * (1.0f / D) + EPS);
        GAS unsigned long long* o8 = (GAS unsigned long long*)(HX + (size_t)row * D) + lane;
#pragma unroll
        for (int j = 0; j < 4; ++j) {
            const int col = 4 * lane + 256 * j;
            const f32x4 g = *(const GAS f32x4*)(g1 + col), sc = *(const GAS f32x4*)(MOD + mr * INW + 1024 + col), sh = *(const GAS f32x4*)(MOD + mr * INW + col);
            const f32x4 h = v[j] * rs * g * (sc + 1.0f) + sh;
            o8[64 * j] = (unsigned long long)pk2(h.x, h.y) | ((unsigned long long)pk2(h.z, h.w) << 32);
        }
    }
}

constexpr size_t WS_YA = 216 * MiB, WS_YB = 232 * MiB;
constexpr size_t WS_SLU = 216 * MiB;
constexpr size_t WS_SLD = 232 * MiB;
constexpr int G_QS = 0, G_KT = 17408, G_KTT = 34816, G_VT = 53248, G_ST = 71680, G_PL = 106496, G_SEGT = 115712, G_DEC = 117760, G_TOT = 118272;
typedef short s16x8 __attribute__((ext_vector_type(8)));

__device__ __forceinline__ size_t gla_row(bool isctx, int dir, int b, int tau0, int tau) {
    if (isctx) { const int tc = dir ? (CTX - 1 - tau) : tau; return (size_t)(T + b * CTX + tc); }
    const int tx = tau0 + tau; const int t = dir ? (L - 1 - tx) : tx; return (size_t)(b * L + t);
}
template <int MODE>
__device__ __forceinline__ void gla_item(Frame& F, int b, int h, int dir, bool isctx, int tau0, int nch, int oslot, int cbase, int ncomb, float* Odir) {
    const bf16_t* P = (const bf16_t*)(F.ws + WS_P);
    const float* LBv = (const float*)(F.ws + WS_LB);
    float* SLU = (float*)(F.ws + WS_SLU); float* SLD = (float*)(F.ws + WS_SLD);
    LAS unsigned char* lds = F.lds;
    LAS bf16_t* QS = (LAS bf16_t*)(lds + G_QS); LAS bf16_t* KT = (LAS bf16_t*)(lds + G_KT); LAS bf16_t* KTT = (LAS bf16_t*)(lds + G_KTT); LAS bf16_t* VT = (LAS bf16_t*)(lds + G_VT);
    LAS bf16_t* ST = (LAS bf16_t*)(lds + G_ST); LAS bf16_t* PL = (LAS bf16_t*)(lds + G_PL);
    LAS float* SEGT = (LAS float*)(lds + G_SEGT); LAS float* DEC = (LAS float*)(lds + G_DEC); LAS float* TOT = (LAS float*)(lds + G_TOT);
    const int tid = F.tid, lane = F.lane, w = F.wave, kk = tid & 127, seg = tid >> 7, fr = lane & 15, fq = lane >> 4;
    const float lbv = LBv[dir * 512 + h * 128 + kk], oml = 1.0f - lbv;
    const int zc = (dir == 0 ? C_ZF : C_ZB) + h * 128 + kk, qc = C_Q + h * 128 + kk, vc = C_V + h * 128 + kk;
    f32x4 S[8];
#pragma unroll
    for (int vt = 0; vt < 8; ++vt) S[vt] = (f32x4){0.f, 0.f, 0.f, 0.f};
    if (MODE == 1) {
        const f32x4* u0 = (const f32x4*)(SLU + (size_t)cbase * 16384) + (w * 8) * 64 + lane;
#pragma unroll
        for (int vt = 0; vt < 8; ++vt) S[vt] = u0[vt * 64];
        for (int j = 1; j <= ncomb; ++j) {
            const f32x4* uj = (const f32x4*)(SLU + (size_t)(cbase + j) * 16384) + (w * 8) * 64 + lane;
            const f32x4 dj = *(const f32x4*)(SLD + (size_t)(cbase + j) * 128 + 16 * w + 4 * fq);
#pragma unroll
            for (int vt = 0; vt < 8; ++vt) S[vt] = dj * S[vt] + uj[vt * 64];
        }
#pragma unroll
        for (int vt = 0; vt < 8; ++vt) { const unsigned lo = pk2(S[vt][0], S[vt][1]), hi = pk2(S[vt][2], S[vt][3]);
            *(LAS unsigned long long*)(ST + (16 * vt + fr) * 136 + 16 * w + 4 * fq) = (unsigned long long)lo | ((unsigned long long)hi << 32); }
    }
    if (tid < 128) TOT[tid] = 0.f;
    unsigned zr[16], qr[16], vr[16];
#define rowof(c_, j_) gla_row(isctx, dir, b, tau0, (c_) * 64 + (j_))
#define GLA_LOAD(c) do { _Pragma("unroll") for (int i = 0; i < 16; ++i) { const bf16_t* pr = P + rowof((c), seg * 16 + i) * INW; zr[i] = pr[zc]; vr[i] = pr[vc]; if (MODE == 1) qr[i] = pr[qc]; } } while (0)
    GLA_LOAD(0);
    for (int c = 0; c < nch; ++c) {
        float lf[16], kv[16];
#pragma unroll
        for (int i = 0; i < 16; ++i) { const float z = __uint_as_float(zr[i] << 16); const float e = __expf(-z), sg = __builtin_amdgcn_rcpf(1.0f + e);
            lf[i] = __logf(lbv + oml * sg); kv[i] = oml * e * sg; }
#pragma unroll
        for (int i = 1; i < 16; ++i) lf[i] += lf[i - 1];
        SEGT[seg * 128 + kk] = lf[15];
        __syncthreads();
        float off = 0.f, tot = 0.f;
#pragma unroll
        for (int s2 = 0; s2 < 4; ++s2) { const float sv = SEGT[s2 * 128 + kk]; tot += sv; off += (s2 < seg) ? sv : 0.f; }
        unsigned ktp[8], vtp[8];
#pragma unroll
        for (int i = 0; i < 16; i += 2) {
            const float b0 = off + lf[i], b1 = off + lf[i + 1];
            const float k0 = kv[i] * __expf(-b0), k1 = kv[i + 1] * __expf(-b1);
            const unsigned kp = pk2(k0, k1);
            ktp[i >> 1] = kp; vtp[i >> 1] = vr[i] | (vr[i + 1] << 16);
            if (MODE == 1) {
                const float q0 = __uint_as_float(qr[i] << 16) * __expf(b0), q1 = __uint_as_float(qr[i + 1] << 16) * __expf(b1);
                const unsigned qp = pk2(q0, q1);
                const int j = seg * 16 + i;
                QS[j * 136 + kk] = (bf16_t)(qp & 0xffffu); QS[(j + 1) * 136 + kk] = (bf16_t)(qp >> 16);
                KT[j * 136 + kk] = (bf16_t)(kp & 0xffffu); KT[(j + 1) * 136 + kk] = (bf16_t)(kp >> 16);
            }
        }
        { LAS v4u* d1 = (LAS v4u*)(KTT + kk * 72 + seg * 16); v4u o; o.x = ktp[0]; o.y = ktp[1]; o.z = ktp[2]; o.w = ktp[3]; d1[0] = o; o.x = ktp[4]; o.y = ktp[5]; o.z = ktp[6]; o.w = ktp[7]; d1[1] = o;
          LAS v4u* d2 = (LAS v4u*)(VT + kk * 72 + seg * 16); o.x = vtp[0]; o.y = vtp[1]; o.z = vtp[2]; o.w = vtp[3]; d2[0] = o; o.x = vtp[4]; o.y = vtp[5]; o.z = vtp[6]; o.w = vtp[7]; d2[1] = o; }
        if (seg == 0) { DEC[kk] = __expf(tot); TOT[kk] += tot; }
        if (c + 1 < nch) GLA_LOAD(c + 1);
        __syncthreads();
        if (MODE == 1) {
            const int tr = w >> 1;
            f32x4 sc[2] = {(f32x4){0.f, 0.f, 0.f, 0.f}, (f32x4){0.f, 0.f, 0.f, 0.f}};
#pragma unroll
            for (int ks = 0; ks < 4; ++ks) {
                const s16x8 a = *(const LAS s16x8*)(QS + (16 * tr + fr) * 136 + 32 * ks + 8 * fq);
#pragma unroll
                for (int q = 0; q < 2; ++q) { const int tcx = (w & 1) * 2 + q;
                    const s16x8 bb = *(const LAS s16x8*)(KT + (16 * tcx + fr) * 136 + 32 * ks + 8 * fq);
                    sc[q] = __builtin_amdgcn_mfma_f32_16x16x32_bf16(a, bb, sc[q], 0, 0, 0); }
            }
#pragma unroll
            for (int q = 0; q < 2; ++q) { const int tcx = (w & 1) * 2 + q; const int sidx = 16 * tcx + fr;
#pragma unroll
                for (int r = 0; r < 4; ++r) { const int tt = 16 * tr + 4 * fq + r; const float val = (sidx <= tt) ? sc[q][r] : 0.f;
                    PL[tt * 72 + sidx] = (bf16_t)f2bf(val); } }
            __syncthreads();
            const int tb = w & 3;
            f32x4 oc[4];
#pragma unroll
            for (int q = 0; q < 4; ++q) oc[q] = (f32x4){0.f, 0.f, 0.f, 0.f};
#pragma unroll
            for (int ks = 0; ks < 4; ++ks) {
                const s16x8 a = *(const LAS s16x8*)(QS + (16 * tb + fr) * 136 + 32 * ks + 8 * fq);
#pragma unroll
                for (int q = 0; q < 4; ++q) { const int vt = (w >> 2) * 4 + q;
                    const s16x8 bb = *(const LAS s16x8*)(ST + (16 * vt + fr) * 136 + 32 * ks + 8 * fq);
                    oc[q] = __builtin_amdgcn_mfma_f32_16x16x32_bf16(a, bb, oc[q], 0, 0, 0); }
            }
#pragma unroll
            for (int ks = 0; ks < 2; ++ks) {
                const s16x8 a = *(const LAS s16x8*)(PL + (16 * tb + fr) * 72 + 32 * ks + 8 * fq);
#pragma unroll
                for (int q = 0; q < 4; ++q) { const int vt = (w >> 2) * 4 + q;
                    const s16x8 bb = *(const LAS s16x8*)(VT + (16 * vt + fr) * 72 + 32 * ks + 8 * fq);
                    oc[q] = __builtin_amdgcn_mfma_f32_16x16x32_bf16(a, bb, oc[q], 0, 0, 0); }
            }
#pragma unroll
            for (int r = 0; r < 4; ++r) { const size_t row = rowof(c, 16 * tb + 4 * fq + r);
#pragma unroll
                for (int q = 0; q < 4; ++q) { const int vt = (w >> 2) * 4 + q; Odir[row * 512 + h * 128 + 16 * vt + fr] = oc[q][r]; } }
        }
        {
            s16x8 a[2];
#pragma unroll
            for (int ks = 0; ks < 2; ++ks) a[ks] = *(const LAS s16x8*)(KTT + (16 * w + fr) * 72 + 32 * ks + 8 * fq);
#pragma unroll
            for (int vt = 0; vt < 8; ++vt)
#pragma unroll
                for (int ks = 0; ks < 2; ++ks) { const s16x8 bb = *(const LAS s16x8*)(VT + (16 * vt + fr) * 72 + 32 * ks + 8 * fq);
                    S[vt] = __builtin_amdgcn_mfma_f32_16x16x32_bf16(a[ks], bb, S[vt], 0, 0, 0); }
            const f32x4 dv = *(const LAS f32x4*)(DEC + 16 * w + 4 * fq);
#pragma unroll
            for (int vt = 0; vt < 8; ++vt) S[vt] = S[vt] * dv;
        }
        __syncthreads();
        if (MODE == 1 && c + 1 < nch) {
#pragma unroll
            for (int vt = 0; vt < 8; ++vt) { const unsigned lo = pk2(S[vt][0], S[vt][1]), hi = pk2(S[vt][2], S[vt][3]);
                *(LAS unsigned long long*)(ST + (16 * vt + fr) * 136 + 16 * w + 4 * fq) = (unsigned long long)lo | ((unsigned long long)hi << 32); }
        }
    }
#undef GLA_LOAD
#undef rowof
    if (MODE == 0) {
        f32x4* uo = (f32x4*)(SLU + (size_t)oslot * 16384) + (w * 8) * 64 + lane;
#pragma unroll
        for (int vt = 0; vt < 8; ++vt) uo[vt * 64] = S[vt];
        if (tid < 128) SLD[(size_t)oslot * 128 + tid] = __expf(TOT[tid]);
    }
    __syncthreads();
}
__device__ __forceinline__ void gla_pass_a(Frame& F) {
    for (int it = F.vcu; it < 256; it += F.G) {
        const int ch = it >> 4, j = it & 15, b = ch >> 3, h = (ch >> 1) & 3, dir = ch & 1;
        if (j == 0) gla_item<0>(F, b, h, dir, true, 0, CTX / 64, it, 0, 0, nullptr);
        else gla_item<0>(F, b, h, dir, false, (j - 1) * 512, 8, it, 0, 0, nullptr);
    }
}
__device__ __forceinline__ void gla_pass_b(Frame& F, float* Of, float* Ob) {
    for (int it = F.vcu; it < 256; it += F.G) {
        const int ch = it >> 4, scn = it & 15, b = ch >> 3, h = (ch >> 1) & 3, dir = ch & 1;
        gla_item<1>(F, b, h, dir, false, scn * 512, 8, 0, ch * 16, scn, dir ? Ob : Of);
    }
}

typedef float f32x16 __attribute__((ext_vector_type(16)));
__device__ __forceinline__ void hy_pre(Frame& F) {
    const bf16_t* P = (const bf16_t*)(F.ws + WS_P); bf16_t* UT = (bf16_t*)(F.ws + WS_UT);
    const float* cw = F.in[11]; const float* cb = F.in[12];
    LAS bf16_t* scr = (LAS bf16_t*)(F.lds + F.wave * 16384);
    const int lane = F.lane;
    for (int it = F.gw; it < 2 * 128 * 8; it += F.NGW) {
        const int ct = it & 7, tt = (it >> 3) & 127, b = it >> 10, c = ct * 64 + lane, t0 = tt * 64;
        const float wv0 = cw[c], wv1 = cw[1536 + c], wv2 = cw[3072 + c], bv = cb[c];
        const float wx0 = cw[512 + c], wx1 = cw[1536 + 512 + c], wx2 = cw[3072 + 512 + c], bx = cb[512 + c];
        const bf16_t* pb = P + (size_t)b * L * INW + C_HY + c;
        float vm = 0.f, xm = 0.f, v0, x0;
        if (t0 > 0) { vm = bf2f_(pb[(size_t)(t0 - 1) * INW]); xm = bf2f_(pb[(size_t)(t0 - 1) * INW + 512]); }
        v0 = bf2f_(pb[(size_t)t0 * INW]); x0 = bf2f_(pb[(size_t)t0 * INW + 512]);
#pragma unroll 8
        for (int j = 0; j < 64; j += 2) {
            float vp = 0.f, xp = 0.f, vp2 = 0.f, xp2 = 0.f;
            if (t0 + j + 1 < L) { vp = bf2f_(pb[(size_t)(t0 + j + 1) * INW]); xp = bf2f_(pb[(size_t)(t0 + j + 1) * INW + 512]); }
            if (t0 + j + 2 < L) { vp2 = bf2f_(pb[(size_t)(t0 + j + 2) * INW]); xp2 = bf2f_(pb[(size_t)(t0 + j + 2) * INW + 512]); }
            const float u0 = (bv + wv0 * vm + wv1 * v0 + wv2 * vp) * (bx + wx0 * xm + wx1 * x0 + wx2 * xp);
            const float u1 = (bv + wv0 * v0 + wv1 * vp + wv2 * vp2) * (bx + wx0 * x0 + wx1 * xp + wx2 * xp2);
            *(LAS unsigned*)(scr + lane * 72 + j) = pk2(u0, u1);
            vm = vp; xm = xp; v0 = vp2; x0 = xp2;
        }
        LDS_WAIT(); asm volatile("" ::: "memory");
#pragma unroll
        for (int q = 0; q < 8; ++q) { const int row = (lane >> 3) + 8 * q, pc = lane & 7;
            const v4u val = *(const LAS v4u*)(scr + row * 72 + pc * 8);
            *(GAS v4u*)(UT + ((size_t)(b * 512 + ct * 64 + row)) * L + t0 + pc * 8) = val; }
        LDS_WAIT(); asm volatile("" ::: "memory");
    }
}
constexpr int HY_UOFF = 0, HY_ZOFF = 73728, HY_FOFF = 73984, HY_FWIN = 135 * 128, HY_NG = 16;
__device__ __forceinline__ void hy_conv(Frame& F) {
    const bf16_t* UT = (const bf16_t*)(F.ws + WS_UT); const bf16_t* GR = (const bf16_t*)(F.ws + WS_GR); bf16_t* YT = (bf16_t*)(F.ws + WS_YT);
    LAS unsigned char* lds = F.lds;
    const int tid = F.tid, lane = F.lane, w = F.wave, ci = w >> 2, cwv = w & 3, b = cwv >> 1, r = lane & 31, hh = lane >> 5;
    const int s0a = (cwv & 1) ? 32 : 0, s0b = (cwv & 1) ? 64 : 96;
    for (int it = F.vcu; it < 256; it += F.G) {
        const int c0 = 2 * it;
#pragma unroll
        for (int q = 0; q < 8; ++q) { const int ch = tid + q * NTHR, row = ch >> 10, cr = ch & 1023, cc = row >> 1, bb = row & 1;
            const v4u val = *(const GAS v4u*)(UT + ((size_t)(bb * 512 + c0 + cc)) * L + cr * 8);
            *(LAS v4u*)(lds + HY_UOFF + (row * 128 + (cr >> 3)) * 144 + (cr & 7) * 16) = val; }
        if (tid < 9) *(LAS v4u*)(lds + HY_ZOFF + tid * 16) = (v4u){0u, 0u, 0u, 0u};
        const int wc = tid / 135, wq = tid % 135;
        v4u wl0, wl1;
#define HY_WLOAD(g_) do { if (tid < 270) { const int qb_ = 1016 - 8 * (-112 + 16 * (g_)); const int q_ = qb_ + wq; \
            if (q_ >= 0 && q_ < 2047) { const GAS v4u* src_ = (const GAS v4u*)(GR + (size_t)(c0 + wc) * 16384 + 8 * q_); wl0 = src_[0]; wl1 = src_[1]; } \
            else { wl0 = (v4u){0u, 0u, 0u, 0u}; wl1 = wl0; } } } while (0)
#define HY_WSTORE(buf_) do { if (tid < 270) { const unsigned ww_[8] = {wl0.x, wl0.y, wl0.z, wl0.w, wl1.x, wl1.y, wl1.z, wl1.w}; \
            LAS v4u* dst_ = (LAS v4u*)(lds + HY_FOFF + ((buf_) * 2 + wc) * HY_FWIN + wq * 128); \
            _Pragma("unroll") for (int m_ = 0; m_ < 4; ++m_) { \
                v4u e_; e_.x = ww_[m_]; e_.y = ww_[m_ + 1]; e_.z = ww_[m_ + 2]; e_.w = ww_[m_ + 3]; dst_[2 * m_] = e_; \
                v4u o_; o_.x = __builtin_amdgcn_alignbit(ww_[m_ + 1], ww_[m_], 16); o_.y = __builtin_amdgcn_alignbit(ww_[m_ + 2], ww_[m_ + 1], 16); \
                o_.z = __builtin_amdgcn_alignbit(ww_[m_ + 3], ww_[m_ + 2], 16); o_.w = __builtin_amdgcn_alignbit(ww_[m_ + 4], ww_[m_ + 3], 16); dst_[2 * m_ + 1] = o_; } } } while (0)
        HY_WLOAD(0); HY_WSTORE(0);
        __syncthreads();
        f32x16 acc[2][2];
#pragma unroll
        for (int m = 0; m < 2; ++m)
#pragma unroll
            for (int s = 0; s < 2; ++s)
#pragma unroll
                for (int e = 0; e < 16; ++e) acc[m][s][e] = 0.f;
        const int aidx = 7 - (r & 7), qa = 1023 - (r >> 3) + hh;
        for (int g = 0; g < HY_NG; ++g) {
            if (g + 1 < HY_NG) HY_WLOAD(g + 1);
            const int dmin = -127 + 16 * g, qbase = 1016 - 8 * (dmin + 15);
            const LAS unsigned char* fw = lds + HY_FOFF + ((g & 1) * 2 + ci) * HY_FWIN + aidx * 16;
            for (int dd = 0; dd < 16; ++dd) {
                const int d = dmin + dd;
                const bool act0 = (d >= s0a - 127) && (d <= s0a + 31), act1 = (d >= s0b - 127) && (d <= s0b + 31);
                if (d > 127 || !(act0 || act1)) continue;
                s16x8 A[2][4];
                const LAS unsigned char* fa = fw + (qa - 8 * d - qbase) * 128;
#pragma unroll
                for (int mt = 0; mt < 2; ++mt)
#pragma unroll
                    for (int ks = 0; ks < 4; ++ks) A[mt][ks] = *(const LAS s16x8*)(fa + (2 * ks - 4 * mt) * 128);
#pragma unroll
                for (int s = 0; s < 2; ++s) {
                    if (s == 0 ? act0 : act1) {
                        const int ip = (s == 0 ? s0a : s0b) + r - d;
                        const LAS unsigned char* ub = (ip >= 0 && ip < 128) ? lds + HY_UOFF + ((ci * 2 + b) * 128 + ip) * 144 + hh * 16 : lds + HY_ZOFF + hh * 16;
                        s16x8 Bf[4];
#pragma unroll
                        for (int ks = 0; ks < 4; ++ks) Bf[ks] = *(const LAS s16x8*)(ub + ks * 32);
#pragma unroll
                        for (int mt = 0; mt < 2; ++mt)
#pragma unroll
                            for (int ks = 0; ks < 4; ++ks) acc[mt][s] = __builtin_amdgcn_mfma_f32_32x32x16_bf16(A[mt][ks], Bf[ks], acc[mt][s], 0, 0, 0);
                    }
                }
            }
            if (g + 1 < HY_NG) HY_WSTORE((g + 1) & 1);
            __syncthreads();
        }
#undef HY_WLOAD
#undef HY_WSTORE
        bf16_t* yb = YT + ((size_t)(b * 512 + c0 + ci)) * L;
#pragma unroll
        for (int s = 0; s < 2; ++s) { const int i = (s == 0 ? s0a : s0b) + r;
#pragma unroll
            for (int mt = 0; mt < 2; ++mt)
#pragma unroll
                for (int g4 = 0; g4 < 4; ++g4) { const f32x16& a = acc[mt][s];
                    const unsigned lo = pk2(a[4 * g4], a[4 * g4 + 1]), hi = pk2(a[4 * g4 + 2], a[4 * g4 + 3]);
                    *(GAS unsigned long long*)(yb + 64 * i + 32 * mt + 8 * g4 + 4 * hh) = (unsigned long long)lo | ((unsigned long long)hi << 32); } }
        __syncthreads();
    }
}
__device__ __forceinline__ void p6_post(Frame& F, const float* Of, const float* Ob, bf16_t* YA, bf16_t* YB) {
    const bf16_t* P = (const bf16_t*)(F.ws + WS_P); const bf16_t* YT = (const bf16_t*)(F.ws + WS_YT);
    const float* cw = F.in[11]; const float* cb = F.in[12]; const float* ng = F.in[10];
    const int lane = F.lane;
    for (int t = F.gw; t < T; t += F.NGW) {
        const f32x4 a0 = *(const GAS f32x4*)(Of + (size_t)t * 512 + 8 * lane), a1 = *(const GAS f32x4*)(Of + (size_t)t * 512 + 8 * lane + 4);
        const f32x4 b0 = *(const GAS f32x4*)(Ob + (size_t)t * 512 + 8 * lane), b1 = *(const GAS f32x4*)(Ob + (size_t)t * 512 + 8 * lane + 4);
        const f32x4 o0 = a0 + b0, o1 = a1 + b1;
        float ss = (o0.x * o0.x + o0.y * o0.y) + (o0.z * o0.z + o0.w * o0.w) + (o1.x * o1.x + o1.y * o1.y) + (o1.z * o1.z + o1.w * o1.w);
        ss += __shfl_xor(ss, 1); ss += __shfl_xor(ss, 2); ss += __shfl_xor(ss, 4); ss += __shfl_xor(ss, 8);
        const float rs = rsqrtf(ss * (1.0f / 128.0f) + EPS);
        const v4u gr = *(const GAS v4u*)(P + (size_t)t * INW + C_G + 8 * lane);
        const f32x4 n0 = *(const GAS f32x4*)(ng + ((8 * lane) & 127)), n1 = *(const GAS f32x4*)(ng + ((8 * lane) & 127) + 4);
        const float g[8] = {__uint_as_float(gr.x << 16), __uint_as_float(gr.x & 0xffff0000u), __uint_as_float(gr.y << 16), __uint_as_float(gr.y & 0xffff0000u),
                            __uint_as_float(gr.z << 16), __uint_as_float(gr.z & 0xffff0000u), __uint_as_float(gr.w << 16), __uint_as_float(gr.w & 0xffff0000u)};
        const float y[8] = {o0.x * rs * n0.x * silu(g[0]), o0.y * rs * n0.y * silu(g[1]), o0.z * rs * n0.z * silu(g[2]), o0.w * rs * n0.w * silu(g[3]),
                            o1.x * rs * n1.x * silu(g[4]), o1.y * rs * n1.y * silu(g[5]), o1.z * rs * n1.z * silu(g[6]), o1.w * rs * n1.w * silu(g[7])};
        v4u o; o.x = pk2(y[0], y[1]); o.y = pk2(y[2], y[3]); o.z = pk2(y[4], y[5]); o.w = pk2(y[6], y[7]);
        *(GAS v4u*)(YA + (size_t)t * 512 + 8 * lane) = o;
    }
    LAS bf16_t* scr = (LAS bf16_t*)(F.lds + F.wave * 16384);
    for (int it = F.gw; it < 2 * 128 * 8; it += F.NGW) {
        const int ct = it & 7, tt = (it >> 3) & 127, b = it >> 10, c = ct * 64 + lane, t0 = tt * 64;
#pragma unroll
        for (int q = 0; q < 8; ++q) { const int row = (lane >> 3) + 8 * q, pc = lane & 7;
            *(LAS v4u*)(scr + row * 72 + pc * 8) = *(const GAS v4u*)(YT + ((size_t)(b * 512 + ct * 64 + row)) * L + t0 + pc * 8); }
        LDS_WAIT(); asm volatile("" ::: "memory");
        const float w0 = cw[1024 + c], w1 = cw[1536 + 1024 + c], w2 = cw[3072 + 1024 + c], bb = cb[1024 + c];
        const bf16_t* pb = P + (size_t)b * L * INW + C_HY + 1024 + c;
        float xm = 0.f, x0;
        if (t0 > 0) xm = bf2f_(pb[(size_t)(t0 - 1) * INW]);
        x0 = bf2f_(pb[(size_t)t0 * INW]);
        bf16_t* yo = YB + ((size_t)b * L + t0) * 512 + c;
#pragma unroll 8
        for (int j = 0; j < 64; j += 2) {
            float xp = 0.f, xp2 = 0.f;
            if (t0 + j + 1 < L) xp = bf2f_(pb[(size_t)(t0 + j + 1) * INW]);
            if (t0 + j + 2 < L) xp2 = bf2f_(pb[(size_t)(t0 + j + 2) * INW]);
            const unsigned yy = *(const LAS unsigned*)(scr + lane * 72 + j);
            const float r0 = (bb + w0 * xm + w1 * x0 + w2 * xp) * __uint_as_float(yy << 16);
            const float r1 = (bb + w0 * x0 + w1 * xp + w2 * xp2) * __uint_as_float(yy & 0xffff0000u);
            yo[(size_t)j * 512] = (bf16_t)f2bf(r0); yo[(size_t)(j + 1) * 512] = (bf16_t)f2bf(r1);
            xm = xp; x0 = xp2;
        }
        LDS_WAIT(); asm volatile("" ::: "memory");
    }
}

constexpr size_t WS_MIXED = 248 * MiB;
constexpr size_t WS_GU_T = 18 * MiB;
constexpr size_t WS_DN_T = 82 * MiB;
constexpr size_t WS_H2 = 114 * MiB;
constexpr size_t WS_HS = 146 * MiB;
constexpr size_t WS_HID = 226 * MiB;
constexpr size_t WS_Y = 114 * MiB;
constexpr size_t WS_TOKE = 266 * MiB;
constexpr size_t WS_TOKW = 266 * MiB + 128 * 1024;
constexpr size_t WS_TOKS = 266 * MiB + 256 * 1024;
constexpr size_t WS_SLOTW = 266 * MiB + 384 * 1024;
constexpr size_t WS_TILEE = 266 * MiB + 640 * 1024;
constexpr int CW_CNT = 8192, CW_FILL = 8192 + 64;
constexpr int MAXTILES = 160;

__device__ __forceinline__ void transpose_tile(const float* W, int N, int k0, int n0, bf16_t* WT, int orow0, int ldk, int kout0, LAS float* scr, int lane) {
#pragma unroll 8
    for (int i = 0; i < 32; ++i) { const int kk = 2 * i + (lane >> 5); scr[kk * 33 + (lane & 31)] = W[(size_t)(k0 + kk) * N + n0 + (lane & 31)]; }
    LDS_WAIT(); asm volatile("" ::: "memory");
    const int c = lane & 7;
#pragma unroll
    for (int j = 0; j < 4; ++j) { const int n = (lane >> 3) + 8 * j; const LAS float* s = scr + (8 * c) * 33 + n;
        v4u o; o.x = pk2(s[0 * 33], s[1 * 33]); o.y = pk2(s[2 * 33], s[3 * 33]); o.z = pk2(s[4 * 33], s[5 * 33]); o.w = pk2(s[6 * 33], s[7 * 33]);
        *(GAS v4u*)(WT + (size_t)(orow0 + n) * ldk + kout0 + 8 * c) = o; }
    LDS_WAIT(); asm volatile("" ::: "memory");
}
__device__ __forceinline__ void p9_router(Frame& F) {
    const float* X1 = F.out; const float* g2 = F.in[7]; const float* MOD = (const float*)(F.ws + WS_MOD);
    const float* wg = F.in[24]; const float* bg = F.in[25]; const float* we = F.in[26]; const float* be = F.in[27];
    bf16_t* H2 = (bf16_t*)(F.ws + WS_H2); int* toke = (int*)(F.ws + WS_TOKE); float* tokw = (float*)(F.ws + WS_TOKW);
    unsigned* cnt = (unsigned*)(F.ws + WS_CTL) + CW_CNT;
    const int lane = F.lane;
    for (int t = F.gw; t < T; t += F.NGW) {
        const int b = t >> 13;
        f32x4 v[4]; float ss = 0.f;
#pragma unroll
        for (int j = 0; j < 4; ++j) { v[j] = *(const GAS f32x4*)(X1 + (size_t)t * D + 4 * lane + 256 * j); ss += (v[j].x * v[j].x + v[j].y * v[j].y) + (v[j].z * v[j].z + v[j].w * v[j].w); }
        const float rs = rsqrtf(wave_sum(ss) * (1.0f / D) + EPS);
        float pg[4] = {0.f, 0.f, 0.f, 0.f};
        GAS unsigned long long* o8 = (GAS unsigned long long*)(H2 + (size_t)t * D) + lane;
#pragma unroll
        for (int j = 0; j < 4; ++j) { const int col = 4 * lane + 256 * j;
            const f32x4 g = *(const GAS f32x4*)(g2 + col), sc = *(const GAS f32x4*)(MOD + b * INW + 4096 + col), sh = *(const GAS f32x4*)(MOD + b * INW + 3072 + col);
            v[j] = v[j] * rs * g * (sc + 1.0f) + sh;
            o8[64 * j] = (unsigned long long)pk2(v[j].x, v[j].y) | ((unsigned long long)pk2(v[j].z, v[j].w) << 32);
#pragma unroll
            for (int e = 0; e < 4; ++e) { const f32x4 wr = *(const GAS f32x4*)(wg + (size_t)(col + e) * 4); const float hv = v[j][e];
                pg[0] += hv * wr.x; pg[1] += hv * wr.y; pg[2] += hv * wr.z; pg[3] += hv * wr.w; } }
#pragma unroll
        for (int q = 0; q < 4; ++q) pg[q] = wave_sum(pg[q]) + bg[q];
        int gi = 0; float lmax = pg[0];
#pragma unroll
        for (int q = 1; q < 4; ++q) if (pg[q] > lmax) { lmax = pg[q]; gi = q; }
        float den = 0.f;
#pragma unroll
        for (int q = 0; q < 4; ++q) den += expf(pg[q] - lmax);
        const float ptop = 1.0f / den;
        float pe[8] = {0.f, 0.f, 0.f, 0.f, 0.f, 0.f, 0.f, 0.f};
        const float* weg = we + (size_t)gi * D * 8;
#pragma unroll
        for (int j = 0; j < 4; ++j)
#pragma unroll
            for (int e = 0; e < 4; ++e) { const int col = 4 * lane + 256 * j + e; const f32x4 w0 = *(const GAS f32x4*)(weg + (size_t)col * 8), w1 = *(const GAS f32x4*)(weg + (size_t)col * 8 + 4); const float hv = v[j][e];
                pe[0] += hv * w0.x; pe[1] += hv * w0.y; pe[2] += hv * w0.z; pe[3] += hv * w0.w; pe[4] += hv * w1.x; pe[5] += hv * w1.y; pe[6] += hv * w1.z; pe[7] += hv * w1.w; }
#pragma unroll
        for (int q = 0; q < 8; ++q) pe[q] = wave_sum(pe[q]) + be[gi * 8 + q];
        float l1 = pe[0]; int i1 = 0;
#pragma unroll
        for (int q = 1; q < 8; ++q) if (pe[q] > l1) { l1 = pe[q]; i1 = q; }
        float l2 = -3.0e38f; int i2 = 0;
#pragma unroll
        for (int q = 0; q < 8; ++q) if (q != i1 && pe[q] > l2) { l2 = pe[q]; i2 = q; }
        const float e2 = expf(l2 - l1);
        if (lane == 0) {
            const int ea = gi * 8 + i1, eb = gi * 8 + i2;
            toke[t * 2] = ea; toke[t * 2 + 1] = eb;
            tokw[t * 2] = ptop / (1.0f + e2); tokw[t * 2 + 1] = ptop * e2 / (1.0f + e2);
            atomicAdd(cnt + ea, 1u); atomicAdd(cnt + eb, 1u);
        }
    }
    LAS float* scr = (LAS float*)(F.lds + F.wave * 16384);
    bf16_t* GU = (bf16_t*)(F.ws + WS_GU_T); bf16_t* DN = (bf16_t*)(F.ws + WS_DN_T);
    for (int it = F.gw; it < 32 * 768; it += F.NGW) {
        const int e = it / 768, r = it % 768;
        if (r < 512) {
            const int up = r >> 8, q = r & 255, kb = q >> 4, nb = q & 15, f0 = nb * 32;
            const float* W = (up ? F.in[29] : F.in[28]) + (size_t)e * D * 512;
            transpose_tile(W, 512, kb * 64, f0, GU, e * 1024 + (f0 >> 7) * 256 + up * 128 + (f0 & 127), D, kb * 64, scr, lane);
        } else {
            const int q = r - 512, kb = q >> 5, nb = q & 31;
            const float* W = F.in[30] + (size_t)e * 512 * D;
            transpose_tile(W, D, kb * 64, nb * 32, DN, e * 1024 + nb * 32, 512, kb * 64, scr, lane);
        }
    }
}
__device__ __forceinline__ void p10_scatter(Frame& F) {
    const unsigned* cnt = (const unsigned*)(F.ws + WS_CTL) + CW_CNT; unsigned* fill = (unsigned*)(F.ws + WS_CTL) + CW_FILL;
    const int* toke = (const int*)(F.ws + WS_TOKE); const float* tokw = (const float*)(F.ws + WS_TOKW); int* toks = (int*)(F.ws + WS_TOKS);
    float* slotw = (float*)(F.ws + WS_SLOTW); int* tilee = (int*)(F.ws + WS_TILEE);
    const bf16_t* H2 = (const bf16_t*)(F.ws + WS_H2); bf16_t* HS = (bf16_t*)(F.ws + WS_HS);
    LAS int* segoff = (LAS int*)(F.lds);
    if (F.tid == 0) { int off = 0; for (int e = 0; e < 32; ++e) { segoff[e] = off; off += ((int)__hip_atomic_load(cnt + e, __ATOMIC_RELAXED, __HIP_MEMORY_SCOPE_AGENT) + 255) & ~255; } segoff[32] = off; }
    __syncthreads();
    if (blockIdx.x == 0 && F.tid < 32) { const int e = F.tid, t0 = segoff[e] >> 8, t1 = segoff[e + 1] >> 8; for (int i = t0; i < t1; ++i) tilee[i] = e; if (e == 31) tilee[MAXTILES] = t1; }
    const int lane = F.lane;
    for (int i = F.gw; i < T * 2; i += F.NGW) {
        const int e = toke[i]; int s = 0;
        if (lane == 0) s = segoff[e] + (int)atomicAdd(fill + e, 1u);
        s = __shfl(s, 0);
        if (lane == 0) { toks[i] = s; slotw[s] = tokw[i]; }
        const GAS v4u* src = (const GAS v4u*)(H2 + (size_t)(i >> 1) * D); GAS v4u* dst = (GAS v4u*)(HS + (size_t)s * D);
        dst[lane] = src[lane]; dst[lane + 64] = src[lane + 64];
    }
    __syncthreads();
}
__device__ __forceinline__ void p13_final(Frame& F) {
    const bf16_t* Y = (const bf16_t*)(F.ws + WS_Y); const int* toks = (const int*)(F.ws + WS_TOKS); const float* MOD = (const float*)(F.ws + WS_MOD); const float* fg = F.in[31];
    const int lane = F.lane;
    for (int t = F.gw; t < T; t += F.NGW) {
        const int b = t >> 13, s0 = toks[2 * t], s1 = toks[2 * t + 1];
        f32x4 v[4]; float ss = 0.f;
#pragma unroll
        for (int j = 0; j < 4; ++j) { const int col = 4 * lane + 256 * j;
            const f32x4 x = *(const GAS f32x4*)(F.out + (size_t)t * D + col), gt = *(const GAS f32x4*)(MOD + b * INW + 5120 + col);
            const unsigned long long ya = *(const GAS unsigned long long*)(Y + (size_t)s0 * D + col), yb = *(const GAS unsigned long long*)(Y + (size_t)s1 * D + col);
            f32x4 m;
            m.x = __uint_as_float((unsigned)ya << 16) + __uint_as_float((unsigned)yb << 16);
            m.y = __uint_as_float((unsigned)ya & 0xffff0000u) + __uint_as_float((unsigned)yb & 0xffff0000u);
            m.z = __uint_as_float((unsigned)(ya >> 32) << 16) + __uint_as_float((unsigned)(yb >> 32) << 16);
            m.w = __uint_as_float((unsigned)(ya >> 32) & 0xffff0000u) + __uint_as_float((unsigned)(yb >> 32) & 0xffff0000u);
            v[j] = x + gt * m; ss += (v[j].x * v[j].x + v[j].y * v[j].y) + (v[j].z * v[j].z + v[j].w * v[j].w); }
        const float rs = rsqrtf(wave_sum(ss) * (1.0f / D) + EPS);
#pragma unroll
        for (int j = 0; j < 4; ++j) { const int col = 4 * lane + 256 * j; const f32x4 g = *(const GAS f32x4*)(fg + col);
            *(GAS f32x4*)(F.out + (size_t)t * D + col) = v[j] * rs * g; }
    }
}

#ifndef MK_HYBRID
#define MK_HYBRID 0
#endif
__global__ void __launch_bounds__(NTHR, 2) mega(Args args) {
    extern __shared__ __attribute__((aligned(16))) unsigned char lds_raw[];
    Frame F;
    F.lds = (LAS unsigned char*)lds_raw;
    F.tid = threadIdx.x; F.lane = F.tid & 63; F.wave = __builtin_amdgcn_readfirstlane(F.tid >> 6);
    F.G = gridDim.x; { const int bx = blockIdx.x; F.vcu = (F.G % 8 == 0) ? (bx % 8) * (F.G / 8) + bx / 8 : bx; }
    F.gw = F.vcu * NWAVES + F.wave; F.NGW = F.G * NWAVES;
    F.in = args.in; F.out = args.out; F.ws = args.ws;
    volatile LAS unsigned* MISC = (volatile LAS unsigned*)(F.lds + MISC_OFF);
    if (F.tid < 64) MISC[F.tid] = 0u;
    __syncthreads();
    XcdBarrier bar = xcd_barrier_post((unsigned*)(F.ws + WS_CTL) + CW_BAR, MISC + 8);
    const int lo = args.ph_lo, hi = args.ph_hi;
#define IN(k) (lo <= (k) && (k) < hi)
#define SEAM(k) do { if (IN(k) && IN((k) + 1)) xcd_barrier(bar); } while (0)
    if (IN(0)) { p0_prologue(F); } SEAM(0);
    if (IN(1)) { p1_prep<MK_HYBRID == 1>(F); } SEAM(1);
    if (IN(2)) {
        pg8::Gemm g{(const bf16_t*)(F.ws + WS_HX), (const bf16_t*)(F.ws + WS_WIN_T), MR, INW, D};
        pg8::StaticOrder S; S.init(MR, INW, F.G, (int)blockIdx.x);
        pg8::EpiBf16Store E{(bf16_t*)(F.ws + WS_P), INW};
        pg8::gemm_phase<pg8::EpiBf16Store, pg8::StaticOrder, true, true>(F.lds, g, S, E);
    } SEAM(2);
    if (IN(3)) { gla_pass_a(F); hy_pre(F); } SEAM(3);
    if (IN(4)) { hy_conv(F); } SEAM(4);
    if (IN(5)) { gla_pass_b(F, F.out, F.out + (size_t)T * 512); } SEAM(5);
    if (IN(6)) { p6_post(F, F.out, F.out + (size_t)T * 512, (bf16_t*)(F.ws + WS_YA), (bf16_t*)(F.ws + WS_YB)); } SEAM(6);
    if (IN(7)) {
        pg8::StaticOrder S; S.init(T, D, F.G, (int)blockIdx.x);
        const bf16_t* Pg = (const bf16_t*)(F.ws + WS_P) + C_GL;
        { pg8::Gemm g{(const bf16_t*)(F.ws + WS_YA), (const bf16_t*)(F.ws + WS_WA_T), T, D, 512};
          pg8::EpiGate1 E{F.out, Pg};
          pg8::gemm_phase<pg8::EpiGate1, pg8::StaticOrder, true, true>(F.lds, g, S, E); }
        { pg8::Gemm g{(const bf16_t*)(F.ws + WS_YB), (const bf16_t*)(F.ws + WS_WB_T), T, D, 512};
          pg8::EpiGate2 E{F.out, (bf16_t*)(F.ws + WS_MIXED), Pg};
          pg8::gemm_phase<pg8::EpiGate2, pg8::StaticOrder, true, true>(F.lds, g, S, E); }
    } SEAM(7);
    if (IN(8)) {
        pg8::Gemm g{(const bf16_t*)(F.ws + WS_MIXED), (const bf16_t*)(F.ws + WS_WO_T), T, D, D};
        pg8::StaticOrder S; S.init(T, D, F.G, (int)blockIdx.x);
        pg8::EpiX1 E{F.in[0], F.out, (const float*)(F.ws + WS_MOD) + 2048, (const float*)(F.ws + WS_PER), (const float*)(F.ws + WS_PEC)};
        pg8::gemm_phase<pg8::EpiX1, pg8::StaticOrder, true, true>(F.lds, g, S, E);
    } SEAM(8);
    if (IN(9)) { p9_router(F); } SEAM(9);
    if (IN(10)) { p10_scatter(F); } SEAM(10);
    if (IN(11)) {
        const int* tilee = (const int*)(F.ws + WS_TILEE);
        pg8::Gemm g{(const bf16_t*)(F.ws + WS_HS), (const bf16_t*)(F.ws + WS_GU_T), 0, 0, D};
        pg8::MoeOrder S{tilee, tilee[MAXTILES], F.G, F.vcu};
        pg8::EpiHid E{(bf16_t*)(F.ws + WS_HID), (const float*)(F.ws + WS_SLOTW)};
        pg8::gemm_phase<pg8::EpiHid, pg8::MoeOrder, true, true>(F.lds, g, S, E);
    } SEAM(11);
    if (IN(12)) {
        const int* tilee = (const int*)(F.ws + WS_TILEE);
        pg8::Gemm g{(const bf16_t*)(F.ws + WS_HID), (const bf16_t*)(F.ws + WS_DN_T), 0, 0, 512};
        pg8::MoeOrder S{tilee, tilee[MAXTILES], F.G, F.vcu};
        pg8::EpiY E{(bf16_t*)(F.ws + WS_Y)};
        pg8::gemm_phase<pg8::EpiY, pg8::MoeOrder, true, true>(F.lds, g, S, E);
    } SEAM(12);
    if (IN(13)) { p13_final(F); }
#undef IN
#undef SEAM
}
}

extern "C" void kernel_launch(void* const* d_in, const int* in_sizes, int n_in, void* d_out, int out_size, void* d_ws, size_t ws_size, hipStream_t stream) {
    using namespace mk;
    static int grid = 0;
    if (grid == 0) {
        if (n_in != 32 || ws_size < 312 * MiB) { fprintf(stderr, "kernel_launch: unexpected n_in %d or ws_size %zu\n", n_in, ws_size); grid = -1; return; }
        int dev = 0, cus = 0, per_cu = 0;
        if (hipGetDevice(&dev) != hipSuccess || hipDeviceGetAttribute(&cus, hipDeviceAttributeMultiprocessorCount, dev) != hipSuccess) { grid = -1; return; }
        if (hipFuncSetAttribute((const void*)mega, hipFuncAttributeMaxDynamicSharedMemorySize, LDS_BYTES) != hipSuccess) { fprintf(stderr, "kernel_launch: hipFuncSetAttribute failed\n"); grid = -1; return; }
        if (hipOccupancyMaxActiveBlocksPerMultiprocessor(&per_cu, (const void*)mega, NTHR, LDS_BYTES) != hipSuccess || per_cu < 1) { fprintf(stderr, "kernel_launch: occupancy query says %d\n", per_cu); }
        (void)hipGetLastError();
        grid = cus;
    }
    if (grid < 0) return;
    (void)hipMemsetAsync((char*)d_ws + WS_CTL, 0, CTL_ZERO_BYTES, stream);
    Args a{};
    for (int i = 0; i < 32; ++i) a.in[i] = (const float*)d_in[i];
    a.out = (float*)d_out; a.ws = (unsigned char*)d_ws; a.ph_lo = 0; a.ph_hi = 14;
    hipLaunchKernelGGL(mega, dim3(grid), dim3(NTHR), LDS_BYTES, stream, a);
#if MK_HYBRID == 2
    nv::tail_from_YAB(d_in, d_out, d_ws, stream);
#endif
}
```

```cpp
#include <hip/hip_runtime.h>
#include <cstdio>
#include <cstdint>

namespace nv {
constexpr int NB = 2, L = 8192, D = 1024, T = NB * L, CTX = 256, TC = NB * CTX, MR = T + TC;
constexpr int INW = 6144, HK = 512, HV = 512, HYW = 512, NH = 4, DK = 128;
constexpr int C_Q = 0, C_ZF = 512, C_ZB = 1024, C_V = 1536, C_G = 2048, C_HY = 2560, C_GL = 4096;
constexpr int NG = 4, NE = 8, NEXP = 32, DF = 512;
constexpr int MAXSLOT = 34816;
constexpr float EPS = 1e-6f;
typedef unsigned short bf16_t;

__device__ __forceinline__ float bf2f(bf16_t v) { return __uint_as_float(((unsigned)v) << 16); }
__device__ __forceinline__ bf16_t f2bf(float f) { unsigned u = __float_as_uint(f); return (bf16_t)((u + 0x7fffu + ((u >> 16) & 1u)) >> 16); }
__device__ __forceinline__ float sigm(float x) { return 1.0f / (1.0f + expf(-x)); }
__device__ __forceinline__ float silu(float x) { return x * sigm(x); }

constexpr size_t MiB = 1u << 20;
constexpr size_t WS_MOD = 0;
constexpr size_t WS_LB = 128 * 1024;
constexpr size_t WS_CNT = 160 * 1024;
constexpr size_t WS_TILEE = 192 * 1024;
constexpr size_t WS_TOKE = 256 * 1024;
constexpr size_t WS_TOKW = 512 * 1024;
constexpr size_t WS_TOKS = 768 * 1024;
constexpr size_t WS_SLOTT = 1024 * 1024;
constexpr size_t WS_SLOTW = 1280 * 1024;
constexpr size_t WS_P = 4 * MiB;
constexpr size_t WS_R1 = 202 * MiB;
constexpr size_t WS_R2 = 268 * MiB;
constexpr size_t WS_END = 300 * MiB;

__global__ void k_mod(const float* c, const float* c_ctx, const float* ada_w, const float* ada_b, float* mod) {
    const int n = blockIdx.x * 256 + threadIdx.x, r = blockIdx.y;
    const float* cv = r < 2 ? c + r * D : c_ctx;
    float acc = 0.f;
    for (int k = 0; k < D; ++k) acc += silu(cv[k]) * ada_w[(size_t)k * INW + n];
    mod[r * INW + n] = acc + ada_b[n];
}
__global__ void k_lb(const float* hgrn_lb, float* lb) {
    const int i = blockIdx.x * 256 + threadIdx.x;
    const float p0 = hgrn_lb[i], p1 = hgrn_lb[1024 + i];
    lb[i] = 1.0f / (1.0f + expf(p1 - p0));
}
__global__ void k_filter(const float* w1, const float* b1, const float* fr1, const float* w2, const float* b2, const float* fr2, const float* w3, float* GN) {
    __shared__ float z[4][36], h1[4][64], h2[4][64];
    const int tid = threadIdx.x, pl = tid >> 6, j = tid & 63, i = blockIdx.x * 4 + pl;
    const float tl = (float)i / 8191.0f;
    if (j < 33) {
        float v;
        if (j == 0) v = tl;
        else {
            const int band = (j - 1) & 15;
            const float fb = 1e-4f + (float)band * ((15.0f - 1e-4f) / 15.0f);
            const float ang = (6.283185307179586f * (float)i / 8192.0f) * fb;
            v = (j <= 16) ? cosf(ang) : -sinf(ang);
        }
        z[pl][j] = v;
    }
    __syncthreads();
    { float a = b1[j]; for (int m = 0; m < 33; ++m) a += z[pl][m] * w1[m * 64 + j]; h1[pl][j] = sinf(fr1[j] * a); }
    __syncthreads();
    { float a = b2[j]; for (int m = 0; m < 64; ++m) a += h1[pl][m] * w2[m * 64 + j]; h2[pl][j] = sinf(fr2[j] * a); }
    __syncthreads();
    const float la = logf(0.01f) / 1.5f, lbb = logf(0.01f) / 0.3f;
    for (int o = 0; o < 16; ++o) {
        const int n = o * 64 + j;
        float a = 0.f; for (int m = 0; m < 64; ++m) a += h2[pl][m] * w3[m * 1024 + n];
        const int dir = n >> 9, c = n & 511;
        const float delta = fabsf(la + (float)c * ((lbb - la) / 511.0f));
        const float val = a * expf(-tl * delta);
        if (dir == 0) GN[(size_t)(8191 + i) * 512 + c] = val;
        else if (i >= 1) GN[(size_t)(8191 - i) * 512 + c] = val;
    }
}
__global__ void k_prep(const float* x, const float* ctx, const float* g1, const float* mod, float* xpos, float* hx) {
    __shared__ float red[4];
    const int row = blockIdx.x, tid = threadIdx.x;
    const bool isx = row < T;
    const float* src = isx ? x + (size_t)row * D : ctx + (size_t)(row - T) * D;
    const int mr = isx ? (row / L) : 2;
    float v[4]; float ss = 0.f;
#pragma unroll
    for (int e = 0; e < 4; ++e) {
        const int col = tid + e * 256;
        float val = src[col];
        if (isx) {
            const int t = row % L, rr = t / 64, cc = t % 64;
            const int quad = col >> 8, jj = col & 255;
            const float omega = expf(-(float)jj / 256.0f * 9.210340371976184f);
            const float pos = (quad < 2) ? (float)rr : (float)cc;
            const float a = pos * omega;
            val += (quad & 1) ? cosf(a) : sinf(a);
            xpos[(size_t)row * D + col] = val;
        }
        v[e] = val; ss += val * val;
    }
    for (int o = 32; o > 0; o >>= 1) ss += __shfl_xor(ss, o);
    if ((tid & 63) == 0) red[tid >> 6] = ss;
    __syncthreads();
    const float rs = rsqrtf((red[0] + red[1] + red[2] + red[3]) / (float)D + EPS);
#pragma unroll
    for (int e = 0; e < 4; ++e) {
        const int col = tid + e * 256;
        hx[(size_t)row * D + col] = v[e] * rs * g1[col] * (1.0f + mod[mr * INW + 1024 + col]) + mod[mr * INW + col];
    }
}

template <typename TA> __device__ __forceinline__ void load4(const TA* p, float (&o)[4]);
template <> __device__ __forceinline__ void load4<float>(const float* p, float (&o)[4]) { const float4 v = *(const float4*)p; o[0] = v.x; o[1] = v.y; o[2] = v.z; o[3] = v.w; }
template <> __device__ __forceinline__ void load4<bf16_t>(const bf16_t* p, float (&o)[4]) { const uint2 v = *(const uint2*)p; o[0] = __uint_as_float(v.x << 16); o[1] = __uint_as_float(v.x & 0xffff0000u); o[2] = __uint_as_float(v.y << 16); o[3] = __uint_as_float(v.y & 0xffff0000u); }

struct GemmArgs {
    const void* A; const void* A2; const int* rowidx;
    const float* B; const float* B2; const int* tile_expert; size_t bstride;
    int lda, ldb, K, pad;
};
template <typename TA, int NACC, bool DUALA, class Epi>
__global__ void __launch_bounds__(256) k_gemm(GemmArgs g, Epi epi) {
    __shared__ float As[NACC][16][68], Bs[NACC][16][68];
    const int tid = threadIdx.x, tx = tid & 15, ty = tid >> 4;
    const int row0 = blockIdx.y * 64, col0 = blockIdx.x * 64;
    if (g.tile_expert && g.tile_expert[blockIdx.y] < 0) return;
    const size_t boff = g.tile_expert ? (size_t)g.tile_expert[blockIdx.y] * g.bstride : 0;
    const int ar = tid >> 2, ak = (tid & 3) * 4;
    int arow = row0 + ar; if (g.rowidx) { arow = g.rowidx[arow]; if (arow < 0) arow = 0; }
    const TA* ap = (const TA*)g.A + (size_t)arow * g.lda + ak;
    const TA* ap2 = DUALA ? (const TA*)g.A2 + (size_t)arow * g.lda + ak : ap;
    const int bk = tid >> 4, bn = (tid & 15) * 4;
    const float* bp = g.B + boff + (size_t)bk * g.ldb + col0 + bn;
    const float* bp2 = NACC == 2 ? g.B2 + boff + (size_t)bk * g.ldb + col0 + bn : bp;
    float acc[NACC][4][4];
#pragma unroll
    for (int a = 0; a < NACC; ++a)
#pragma unroll
        for (int i = 0; i < 4; ++i)
#pragma unroll
            for (int j = 0; j < 4; ++j) acc[a][i][j] = 0.f;
    for (int k0 = 0; k0 < g.K; k0 += 16) {
        float av[4], av2[4]; load4<TA>(ap + k0, av); if (DUALA) load4<TA>(ap2 + k0, av2);
        const float4 bv = *(const float4*)(bp + (size_t)k0 * g.ldb);
        float4 bv2 = bv; if (NACC == 2) bv2 = *(const float4*)(bp2 + (size_t)k0 * g.ldb);
        __syncthreads();
#pragma unroll
        for (int e = 0; e < 4; ++e) { As[0][ak + e][ar] = av[e]; if (DUALA) As[NACC - 1][ak + e][ar] = av2[e]; }
        *(float4*)&Bs[0][bk][bn] = bv;
        if (NACC == 2) *(float4*)&Bs[NACC - 1][bk][bn] = bv2;
        __syncthreads();
#pragma unroll
        for (int kk = 0; kk < 16; ++kk) {
#pragma unroll
            for (int a = 0; a < NACC; ++a) {
                const float4 a4 = *(const float4*)&As[DUALA ? a : 0][kk][ty * 4];
                const float aa[4] = {a4.x, a4.y, a4.z, a4.w};
                const float4 b4 = *(const float4*)&Bs[a][kk][tx * 4];
                const float bb[4] = {b4.x, b4.y, b4.z, b4.w};
#pragma unroll
                for (int i = 0; i < 4; ++i)
#pragma unroll
                    for (int j = 0; j < 4; ++j) acc[a][i][j] += aa[i] * bb[j];
            }
        }
    }
#pragma unroll
    for (int i = 0; i < 4; ++i)
#pragma unroll
        for (int j = 0; j < 4; ++j) epi(row0 + ty * 4 + i, col0 + tx * 4 + j, acc[0][i][j], acc[NACC - 1][i][j]);
}
struct EpiStoreBf16 { bf16_t* C; long ldc; __device__ void operator()(int r, int c, float a, float) const { C[(size_t)r * ldc + c] = f2bf(a); } };
struct EpiStoreF32 { float* C; long ldc; __device__ void operator()(int r, int c, float a, float) const { C[(size_t)r * ldc + c] = a; } };
struct EpiMerge { bf16_t* MX; const bf16_t* P; __device__ void operator()(int r, int c, float a, float b) const {
    MX[(size_t)r * D + c] = f2bf(sigm(bf2f(P[(size_t)r * INW + C_GL + c])) * a + sigm(bf2f(P[(size_t)r * INW + C_GL + 1024 + c])) * b); } };
struct EpiX1 { float* X; const float* mod; __device__ void operator()(int r, int c, float a, float) const { const int b = r / L; X[(size_t)r * D + c] += mod[b * INW + 2048 + c] * a; } };
struct EpiHid { float* H; const float* slot_w; __device__ void operator()(int r, int c, float g, float u) const { H[(size_t)r * DF + c] = silu(g) * u * slot_w[r]; } };

__global__ void __launch_bounds__(64) k_gla(const bf16_t* P, const float* lb, float* O, int dir) {
    __shared__ float sf[4][128], sk[4][128], sq[4][128];
    const int lane = threadIdx.x, vh = blockIdx.x & 1, h = (blockIdx.x >> 1) & 3, b = blockIdx.x >> 3;
    const int v = vh * 64 + lane;
    float S[128];
#pragma unroll
    for (int k = 0; k < 128; ++k) S[k] = 0.f;
    const float lb0 = lb[dir * 512 + h * 128 + lane], lb1 = lb[dir * 512 + h * 128 + 64 + lane];
    const int zc = (dir == 0 ? C_ZF : C_ZB) + h * 128;
    for (int ph = 0; ph < 2; ++ph) {
        const int n = ph == 0 ? CTX : L;
        const size_t rbase = ph == 0 ? (size_t)(T + b * CTX) : (size_t)b * L;
        for (int g0 = 0; g0 < n; g0 += 4) {
            float vv[4];
#pragma unroll
            for (int j = 0; j < 4; ++j) {
                const int tt = dir == 0 ? (g0 + j) : (n - 1 - g0 - j);
                const bf16_t* pr = P + (rbase + tt) * INW;
                const float z0 = bf2f(pr[zc + lane]), z1 = bf2f(pr[zc + 64 + lane]);
                sf[j][lane] = lb0 + (1.f - lb0) * sigm(z0); sf[j][64 + lane] = lb1 + (1.f - lb1) * sigm(z1);
                sk[j][lane] = (1.f - lb0) * sigm(-z0); sk[j][64 + lane] = (1.f - lb1) * sigm(-z1);
                sq[j][lane] = bf2f(pr[C_Q + h * 128 + lane]); sq[j][64 + lane] = bf2f(pr[C_Q + h * 128 + 64 + lane]);
                vv[j] = bf2f(pr[C_V + h * 128 + v]);
            }
            __syncthreads();
#pragma unroll
            for (int j = 0; j < 4; ++j) {
                float o = 0.f;
#pragma unroll
                for (int k = 0; k < 128; k += 4) {
                    const float4 f4 = *(const float4*)&sf[j][k], k4 = *(const float4*)&sk[j][k], q4 = *(const float4*)&sq[j][k];
                    S[k] = f4.x * S[k] + k4.x * vv[j]; o += S[k] * q4.x;
                    S[k + 1] = f4.y * S[k + 1] + k4.y * vv[j]; o += S[k + 1] * q4.y;
                    S[k + 2] = f4.z * S[k + 2] + k4.z * vv[j]; o += S[k + 2] * q4.z;
                    S[k + 3] = f4.w * S[k + 3] + k4.w * vv[j]; o += S[k + 3] * q4.w;
                }
                if (ph == 1) {
                    const int tt = dir == 0 ? (g0 + j) : (n - 1 - g0 - j);
                    float* op = O + (rbase + tt) * HV + h * 128 + v;
                    if (dir == 0) *op = o; else *op += o;
                }
            }
            __syncthreads();
        }
    }
}
template <typename TO> __device__ __forceinline__ void stv(TO* p, float v);
template <> __device__ __forceinline__ void stv<float>(float* p, float v) { *p = v; }
template <> __device__ __forceinline__ void stv<bf16_t>(bf16_t* p, float v) { *p = f2bf(v); }
template <typename TO>
__global__ void __launch_bounds__(512) k_readout(const float* O, const float* O2, const bf16_t* P, const float* ng, TO* YA, int ldy) {
    __shared__ float red[8];
    const int t = blockIdx.x, c = threadIdx.x, h = c >> 7;
    const float o = O[(size_t)t * HV + c] + (O2 ? O2[(size_t)t * HV + c] : 0.f);
    float ss = o * o;
    for (int m = 32; m > 0; m >>= 1) ss += __shfl_xor(ss, m);
    if ((c & 63) == 0) red[c >> 6] = ss;
    __syncthreads();
    const float rs = rsqrtf((red[2 * h] + red[2 * h + 1]) / 128.0f + EPS);
    const float g = bf2f(P[(size_t)t * INW + C_G + c]);
    stv<TO>(YA + (size_t)t * ldy + c, o * rs * ng[c & 127] * silu(g));
}
__device__ __forceinline__ float conv3(const bf16_t* P, int b, int t, int ch, const float* cw, const float* cb) {
    const size_t r = (size_t)b * L + t;
    float a = cb[ch] + bf2f(P[r * INW + C_HY + ch]) * cw[1536 + ch];
    if (t > 0) a += bf2f(P[(r - 1) * INW + C_HY + ch]) * cw[ch];
    if (t < L - 1) a += bf2f(P[(r + 1) * INW + C_HY + ch]) * cw[2 * 1536 + ch];
    return a;
}
__global__ void k_hy_pre(const bf16_t* P, const float* cw, const float* cb, float* U) {
    const int c = threadIdx.x + (blockIdx.x & 1) * 256, r = blockIdx.x >> 1, b = r / L, t = r % L;
    U[(size_t)r * 512 + c] = conv3(P, b, t, c, cw, cb) * conv3(P, b, t, 512 + c, cw, cb);
}
template <typename TO>
__global__ void __launch_bounds__(256) k_longconv(const float* U, const float* GN, const bf16_t* P, const float* cw, const float* cb, const float* hyd, TO* YB, int ldy) {
    const int tid = threadIdx.x, c = blockIdx.y * 64 + (tid & 63), tg = tid >> 6, b = blockIdx.z;
    const int tbase = blockIdx.x * 64 + tg * 16;
    float acc[16], ep[16], en[16];
#pragma unroll
    for (int i = 0; i < 16; ++i) acc[i] = 0.f;
    const float* ub = U + (size_t)b * L * 512 + c;
    const float* gb = GN + c;
#pragma unroll
    for (int m = 0; m < 16; ++m) ep[m] = gb[(size_t)(8191 + tbase + m) * 512];
    for (int s0 = 0; s0 < L; s0 += 16) {
        const int base = 8191 + tbase - s0;
#pragma unroll
        for (int n = 1; n < 16; ++n) en[n] = gb[(size_t)(base - n) * 512];
        float uv[16];
#pragma unroll
        for (int j = 0; j < 16; ++j) uv[j] = ub[(size_t)(s0 + j) * 512];
#pragma unroll
        for (int j = 0; j < 16; ++j)
#pragma unroll
            for (int i = 0; i < 16; ++i) { const int m = i - j; acc[i] += (m >= 0 ? ep[m] : en[-m]) * uv[j]; }
        if (s0 + 16 < L) {
#pragma unroll
            for (int m = 1; m < 16; ++m) ep[m] = en[16 - m];
            ep[0] = gb[(size_t)(base - 16) * 512];
        }
    }
#pragma unroll
    for (int i = 0; i < 16; ++i) {
        const int t = tbase + i; const size_t r = (size_t)b * L + t;
        const float y = acc[i] + hyd[c] * U[r * 512 + c];
        stv<TO>(YB + r * ldy + c, conv3(P, b, t, 1024 + c, cw, cb) * y);
    }
}
__global__ void __launch_bounds__(256) k_norm2_router(const float* X1, const float* g2, const float* mod, const float* wg, const float* bg, const float* we, const float* be,
                                                     float* H2, int* tok_e, float* tok_w, int* cnt) {
    __shared__ float red[4], part[4][8], lg[8];
    __shared__ int gsel;
    const int t = blockIdx.x, tid = threadIdx.x, b = t / L;
    float v[4], hh[4]; float ss = 0.f;
#pragma unroll
    for (int e = 0; e < 4; ++e) { v[e] = X1[(size_t)t * D + tid + e * 256]; ss += v[e] * v[e]; }
    for (int o = 32; o > 0; o >>= 1) ss += __shfl_xor(ss, o);
    if ((tid & 63) == 0) red[tid >> 6] = ss;
    __syncthreads();
    const float rs = rsqrtf((red[0] + red[1] + red[2] + red[3]) / (float)D + EPS);
#pragma unroll
    for (int e = 0; e < 4; ++e) { const int col = tid + e * 256; hh[e] = v[e] * rs * g2[col] * (1.0f + mod[b * INW + 4096 + col]) + mod[b * INW + 3072 + col]; H2[(size_t)t * D + col] = hh[e]; }
    float pg[4];
#pragma unroll
    for (int gq = 0; gq < 4; ++gq) { float a = 0.f;
#pragma unroll
        for (int e = 0; e < 4; ++e) a += hh[e] * wg[(tid + e * 256) * 4 + gq];
        for (int o = 32; o > 0; o >>= 1) a += __shfl_xor(a, o);
        pg[gq] = a; }
    if ((tid & 63) == 0) { for (int gq = 0; gq < 4; ++gq) part[tid >> 6][gq] = pg[gq]; }
    __syncthreads();
    if (tid == 0) {
        float l[4]; for (int gq = 0; gq < 4; ++gq) l[gq] = part[0][gq] + part[1][gq] + part[2][gq] + part[3][gq] + bg[gq];
        int bi = 0; for (int gq = 1; gq < 4; ++gq) if (l[gq] > l[bi]) bi = gq;
        float den = 0.f; for (int gq = 0; gq < 4; ++gq) den += expf(l[gq] - l[bi]);
        lg[0] = 1.0f / den; gsel = bi;
    }
    __syncthreads();
    const int gi = gsel; const float ptop = lg[0];
    __syncthreads();
    float pe[8];
#pragma unroll
    for (int q = 0; q < 8; ++q) { float a = 0.f;
#pragma unroll
        for (int e = 0; e < 4; ++e) a += hh[e] * we[((size_t)gi * D + tid + e * 256) * 8 + q];
        for (int o = 32; o > 0; o >>= 1) a += __shfl_xor(a, o);
        pe[q] = a; }
    if ((tid & 63) == 0) { for (int q = 0; q < 8; ++q) part[tid >> 6][q] = pe[q]; }
    __syncthreads();
    if (tid == 0) {
        float l[8]; for (int q = 0; q < 8; ++q) l[q] = part[0][q] + part[1][q] + part[2][q] + part[3][q] + be[gi * 8 + q];
        int i1 = 0; for (int q = 1; q < 8; ++q) if (l[q] > l[i1]) i1 = q;
        int i2 = -1; for (int q = 0; q < 8; ++q) if (q != i1 && (i2 < 0 || l[q] > l[i2])) i2 = q;
        const float e2 = expf(l[i2] - l[i1]);
        const int ea = gi * 8 + i1, eb = gi * 8 + i2;
        tok_e[t * 2] = ea; tok_e[t * 2 + 1] = eb;
        tok_w[t * 2] = ptop / (1.0f + e2); tok_w[t * 2 + 1] = ptop * e2 / (1.0f + e2);
        atomicAdd(&cnt[ea], 1); atomicAdd(&cnt[eb], 1);
    }
}
__global__ void k_moe_offsets(int* cnt, int* tile_expert, int* slot_tok) {
    if (threadIdx.x == 0) {
        int off = 0;
        for (int e = 0; e < NEXP; ++e) { cnt[64 + e] = off; const int nt = (cnt[e] + 63) / 64; for (int i = 0; i < nt; ++i) tile_expert[off / 64 + i] = e; off += nt * 64; }
        cnt[64 + NEXP] = off;
        for (int i = off / 64; i < MAXSLOT / 64; ++i) tile_expert[i] = -1;
    }
    __syncthreads();
    for (int i = threadIdx.x; i < MAXSLOT; i += blockDim.x) slot_tok[i] = -1;
}
__global__ void k_moe_scatter(const int* tok_e, const float* tok_w, int* cnt, int* slot_tok, float* slot_w, int* tok_slot) {
    const int i = blockIdx.x * 256 + threadIdx.x;
    const int e = tok_e[i];
    const int s = cnt[64 + e] + atomicAdd(&cnt[32 + e], 1);
    slot_tok[s] = i >> 1; slot_w[s] = tok_w[i]; tok_slot[i] = s;
}
__global__ void __launch_bounds__(256) k_final(const float* X1, const float* Y, const int* tok_slot, const float* mod, const float* fg, float* out) {
    __shared__ float red[4];
    const int t = blockIdx.x, tid = threadIdx.x, b = t / L;
    const int s0 = tok_slot[t * 2], s1 = tok_slot[t * 2 + 1];
    float v[4]; float ss = 0.f;
#pragma unroll
    for (int e = 0; e < 4; ++e) { const int col = tid + e * 256;
        v[e] = X1[(size_t)t * D + col] + mod[b * INW + 5120 + col] * (Y[(size_t)s0 * D + col] + Y[(size_t)s1 * D + col]); ss += v[e] * v[e]; }
    for (int o = 32; o > 0; o >>= 1) ss += __shfl_xor(ss, o);
    if ((tid & 63) == 0) red[tid >> 6] = ss;
    __syncthreads();
    const float rs = rsqrtf((red[0] + red[1] + red[2] + red[3]) / (float)D + EPS);
#pragma unroll
    for (int e = 0; e < 4; ++e) { const int col = tid + e * 256; out[(size_t)t * D + col] = v[e] * rs * fg[col]; }
}
}


namespace nv {
static void tail_from_P(void* const* d_in, void* d_out, void* d_ws, hipStream_t stream) {
    const float* g2 = (const float*)d_in[7]; const float* hgrn_ng = (const float*)d_in[10];
    const float* cw = (const float*)d_in[11]; const float* cb = (const float*)d_in[12];
    const float* fw1 = (const float*)d_in[13]; const float* fb1 = (const float*)d_in[14]; const float* ffr1 = (const float*)d_in[15];
    const float* fw2 = (const float*)d_in[16]; const float* fb2 = (const float*)d_in[17]; const float* ffr2 = (const float*)d_in[18]; const float* fw3 = (const float*)d_in[19];
    const float* hyd = (const float*)d_in[20]; const float* wpa = (const float*)d_in[21]; const float* wpb = (const float*)d_in[22]; const float* wo = (const float*)d_in[23];
    const float* rgw = (const float*)d_in[24]; const float* rgb = (const float*)d_in[25]; const float* rew = (const float*)d_in[26]; const float* reb = (const float*)d_in[27];
    const float* wgate = (const float*)d_in[28]; const float* wup = (const float*)d_in[29]; const float* wdown = (const float*)d_in[30]; const float* fng = (const float*)d_in[31];
    char* ws = (char*)d_ws; float* out = (float*)d_out;
    float* MOD = (float*)(ws + 1 * MiB); float* LB = (float*)(ws + 1 * MiB + 96 * 1024);
    bf16_t* P = (bf16_t*)(ws + 18 * MiB);
    float* GN = (float*)(ws + 216 * MiB); float* O = GN; bf16_t* MIXED = (bf16_t*)GN;
    float* U = (float*)(ws + 248 * MiB); float* YA = U; float* YB = (float*)(ws + 280 * MiB);
    int* CNT = (int*)(ws + 2 * MiB); int* TILEE = (int*)(ws + 2 * MiB + 64 * 1024); int* TOKE = (int*)(ws + 3 * MiB); float* TOKW = (float*)(ws + 4 * MiB); int* TOKS = (int*)(ws + 5 * MiB);
    int* SLOTT = (int*)(ws + 6 * MiB); float* SLOTW = (float*)(ws + 7 * MiB);
    float* H2 = (float*)(ws + 18 * MiB); float* HID = (float*)(ws + 82 * MiB); float* Y = (float*)(ws + 150 * MiB);
    k_filter<<<L / 4, 256, 0, stream>>>(fw1, fb1, ffr1, fw2, fb2, ffr2, fw3, GN);
    k_hy_pre<<<T * 2, 256, 0, stream>>>(P, cw, cb, U);
    k_longconv<float><<<dim3(L / 64, 512 / 64, NB), 256, 0, stream>>>(U, GN, P, cw, cb, hyd, YB, 512);
    k_gla<<<NB * NH * 2, 64, 0, stream>>>(P, LB, O, 0);
    k_gla<<<NB * NH * 2, 64, 0, stream>>>(P, LB, O, 1);
    k_readout<float><<<T, 512, 0, stream>>>(O, nullptr, P, hgrn_ng, YA, 512);
    { GemmArgs g{YA, YB, nullptr, wpa, wpb, nullptr, 0, 512, D, 512, 0}; k_gemm<float, 2, true, EpiMerge><<<dim3(D / 64, T / 64), 256, 0, stream>>>(g, EpiMerge{MIXED, P}); }
    { GemmArgs g{MIXED, nullptr, nullptr, wo, nullptr, nullptr, 0, D, D, D, 0}; k_gemm<bf16_t, 1, false, EpiX1><<<dim3(D / 64, T / 64), 256, 0, stream>>>(g, EpiX1{out, MOD}); }
    (void)hipMemsetAsync(CNT, 0, 1024, stream);
    k_norm2_router<<<T, 256, 0, stream>>>(out, g2, MOD, rgw, rgb, rew, reb, H2, TOKE, TOKW, CNT);
    k_moe_offsets<<<1, 256, 0, stream>>>(CNT, TILEE, SLOTT);
    k_moe_scatter<<<T * 2 / 256, 256, 0, stream>>>(TOKE, TOKW, CNT, SLOTT, SLOTW, TOKS);
    { GemmArgs g{H2, nullptr, SLOTT, wgate, wup, TILEE, (size_t)D * DF, D, DF, D, 0}; k_gemm<float, 2, false, EpiHid><<<dim3(DF / 64, MAXSLOT / 64), 256, 0, stream>>>(g, EpiHid{HID, SLOTW}); }
    { GemmArgs g{HID, nullptr, nullptr, wdown, nullptr, TILEE, (size_t)DF * D, DF, D, DF, 0}; k_gemm<float, 1, false, EpiStoreF32><<<dim3(D / 64, MAXSLOT / 64), 256, 0, stream>>>(g, EpiStoreF32{Y, D}); }
    k_final<<<T, 256, 0, stream>>>(out, Y, TOKS, MOD, fng, out);
}
}

namespace nv {
static void tail_from_O(void* const* d_in, void* d_out, void* d_ws, hipStream_t stream, const float* Of, const float* Ob, bool have_yb) {
    const float* g2 = (const float*)d_in[7]; const float* hgrn_ng = (const float*)d_in[10];
    const float* cw = (const float*)d_in[11]; const float* cb = (const float*)d_in[12];
    const float* fw1 = (const float*)d_in[13]; const float* fb1 = (const float*)d_in[14]; const float* ffr1 = (const float*)d_in[15];
    const float* fw2 = (const float*)d_in[16]; const float* fb2 = (const float*)d_in[17]; const float* ffr2 = (const float*)d_in[18]; const float* fw3 = (const float*)d_in[19];
    const float* hyd = (const float*)d_in[20]; const float* wpa = (const float*)d_in[21]; const float* wpb = (const float*)d_in[22]; const float* wo = (const float*)d_in[23];
    const float* rgw = (const float*)d_in[24]; const float* rgb = (const float*)d_in[25]; const float* rew = (const float*)d_in[26]; const float* reb = (const float*)d_in[27];
    const float* wgate = (const float*)d_in[28]; const float* wup = (const float*)d_in[29]; const float* wdown = (const float*)d_in[30]; const float* fng = (const float*)d_in[31];
    char* ws = (char*)d_ws; float* out = (float*)d_out;
    float* MOD = (float*)(ws + 1 * MiB);
    bf16_t* P = (bf16_t*)(ws + 18 * MiB);
    bf16_t* YA = (bf16_t*)(ws + 2 * MiB); bf16_t* YB = (bf16_t*)(ws + 216 * MiB);
    float* GN = (float*)(ws + 248 * MiB); float* U = (float*)(ws + 280 * MiB); bf16_t* MIXED = (bf16_t*)(ws + 248 * MiB);
    k_readout<bf16_t><<<T, 512, 0, stream>>>(Of, Ob, P, hgrn_ng, YA, 512);
    if (!have_yb) {
        k_filter<<<L / 4, 256, 0, stream>>>(fw1, fb1, ffr1, fw2, fb2, ffr2, fw3, GN);
        k_hy_pre<<<T * 2, 256, 0, stream>>>(P, cw, cb, U);
        k_longconv<bf16_t><<<dim3(L / 64, 512 / 64, NB), 256, 0, stream>>>(U, GN, P, cw, cb, hyd, YB, 512);
    }
    { GemmArgs g{YA, YB, nullptr, wpa, wpb, nullptr, 0, 512, D, 512, 0}; k_gemm<bf16_t, 2, true, EpiMerge><<<dim3(D / 64, T / 64), 256, 0, stream>>>(g, EpiMerge{MIXED, P}); }
    { GemmArgs g{MIXED, nullptr, nullptr, wo, nullptr, nullptr, 0, D, D, D, 0}; k_gemm<bf16_t, 1, false, EpiX1><<<dim3(D / 64, T / 64), 256, 0, stream>>>(g, EpiX1{out, MOD}); }
    int* CNT = (int*)(ws + 250 * MiB); int* TILEE = (int*)(ws + 250 * MiB + 64 * 1024); int* TOKE = (int*)(ws + 251 * MiB); float* TOKW = (float*)(ws + 252 * MiB); int* TOKS = (int*)(ws + 253 * MiB);
    int* SLOTT = (int*)(ws + 254 * MiB); float* SLOTW = (float*)(ws + 255 * MiB);
    float* H2 = (float*)(ws + 18 * MiB); float* HID = (float*)(ws + 82 * MiB); float* Y = (float*)(ws + 256 * MiB);
    H2 = (float*)(ws + 2 * MiB); HID = (float*)(ws + 66 * MiB); Y = (float*)(ws + 134 * MiB); CNT = (int*)(ws + 272 * MiB); TILEE = (int*)(ws + 272 * MiB + 64 * 1024);
    TOKE = (int*)(ws + 273 * MiB); TOKW = (float*)(ws + 274 * MiB); TOKS = (int*)(ws + 275 * MiB); SLOTT = (int*)(ws + 276 * MiB); SLOTW = (float*)(ws + 277 * MiB);
    (void)hipMemsetAsync(CNT, 0, 1024, stream);
    k_norm2_router<<<T, 256, 0, stream>>>(out, g2, MOD, rgw, rgb, rew, reb, H2, TOKE, TOKW, CNT);
    k_moe_offsets<<<1, 256, 0, stream>>>(CNT, TILEE, SLOTT);
    k_moe_scatter<<<T * 2 / 256, 256, 0, stream>>>(TOKE, TOKW, CNT, SLOTT, SLOTW, TOKS);
    { GemmArgs g{H2, nullptr, SLOTT, wgate, wup, TILEE, (size_t)D * DF, D, DF, D, 0}; k_gemm<float, 2, false, EpiHid><<<dim3(DF / 64, MAXSLOT / 64), 256, 0, stream>>>(g, EpiHid{HID, SLOTW}); }
    { GemmArgs g{HID, nullptr, nullptr, wdown, nullptr, TILEE, (size_t)DF * D, DF, D, DF, 0}; k_gemm<float, 1, false, EpiStoreF32><<<dim3(D / 64, MAXSLOT / 64), 256, 0, stream>>>(g, EpiStoreF32{Y, D}); }
    k_final<<<T, 256, 0, stream>>>(out, Y, TOKS, MOD, fng, out);
}
}

namespace nv {
__global__ void k_xpos(const float* x, float* xpos) {
    const int row = blockIdx.x, tid = threadIdx.x, t = row % L, rr = t / 64, cc = t % 64;
    for (int e = 0; e < 4; ++e) { const int col = tid + e * 256, quad = col >> 8, jj = col & 255;
        const float omega = expf(-(float)jj / 256.0f * 9.210340371976184f), a = ((quad < 2) ? (float)rr : (float)cc) * omega;
        xpos[(size_t)row * D + col] = x[(size_t)row * D + col] + ((quad & 1) ? cosf(a) : sinf(a)); }
}
static void tail_from_YAB(void* const* d_in, void* d_out, void* d_ws, hipStream_t stream) {
    const float* g2 = (const float*)d_in[7];
    const float* wpa = (const float*)d_in[21]; const float* wpb = (const float*)d_in[22]; const float* wo = (const float*)d_in[23];
    const float* rgw = (const float*)d_in[24]; const float* rgb = (const float*)d_in[25]; const float* rew = (const float*)d_in[26]; const float* reb = (const float*)d_in[27];
    const float* wgate = (const float*)d_in[28]; const float* wup = (const float*)d_in[29]; const float* wdown = (const float*)d_in[30]; const float* fng = (const float*)d_in[31];
    char* ws = (char*)d_ws; float* out = (float*)d_out;
    float* MOD = (float*)(ws + 1 * MiB);
    bf16_t* P = (bf16_t*)(ws + 18 * MiB); bf16_t* YAB = (bf16_t*)(ws + 216 * MiB); bf16_t* MIXED = (bf16_t*)(ws + 248 * MiB);
    k_xpos<<<T, 256, 0, stream>>>((const float*)d_in[0], out);
    { GemmArgs g{YAB, YAB + 512, nullptr, wpa, wpb, nullptr, 0, 1024, D, 512, 0}; k_gemm<bf16_t, 2, true, EpiMerge><<<dim3(D / 64, T / 64), 256, 0, stream>>>(g, EpiMerge{MIXED, P}); }
    { GemmArgs g{MIXED, nullptr, nullptr, wo, nullptr, nullptr, 0, D, D, D, 0}; k_gemm<bf16_t, 1, false, EpiX1><<<dim3(D / 64, T / 64), 256, 0, stream>>>(g, EpiX1{out, MOD}); }
    float* H2 = (float*)(ws + 2 * MiB); float* HID = (float*)(ws + 66 * MiB); float* Y = (float*)(ws + 134 * MiB); int* CNT = (int*)(ws + 272 * MiB); int* TILEE = (int*)(ws + 272 * MiB + 64 * 1024);
    int* TOKE = (int*)(ws + 273 * MiB); float* TOKW = (float*)(ws + 274 * MiB); int* TOKS = (int*)(ws + 275 * MiB); int* SLOTT = (int*)(ws + 276 * MiB); float* SLOTW = (float*)(ws + 277 * MiB);
    (void)hipMemsetAsync(CNT, 0, 1024, stream);
    k_norm2_router<<<T, 256, 0, stream>>>(out, g2, MOD, rgw, rgb, rew, reb, H2, TOKE, TOKW, CNT);
    k_moe_offsets<<<1, 256, 0, stream>>>(CNT, TILEE, SLOTT);
    k_moe_scatter<<<T * 2 / 256, 256, 0, stream>>>(TOKE, TOKW, CNT, SLOTT, SLOTW, TOKS);
    { GemmArgs g{H2, nullptr, SLOTT, wgate, wup, TILEE, (size_t)D * DF, D, DF, D, 0}; k_gemm<float, 2, false, EpiHid><<<dim3(DF / 64, MAXSLOT / 64), 256, 0, stream>>>(g, EpiHid{HID, SLOTW}); }
    { GemmArgs g{HID, nullptr, nullptr, wdown, nullptr, TILEE, (size_t)DF * D, DF, D, DF, 0}; k_gemm<float, 1, false, EpiStoreF32><<<dim3(D / 64, MAXSLOT / 64), 256, 0, stream>>>(g, EpiStoreF32{Y, D}); }
    k_final<<<T, 256, 0, stream>>>(out, Y, TOKS, MOD, fng, out);
}
}

namespace pg8 {
#define PG8_LAS __attribute__((address_space(3)))
typedef unsigned short bf16_t;
typedef short bf16x8 __attribute__((ext_vector_type(8)));
typedef float f32x4 __attribute__((ext_vector_type(4)));
typedef unsigned u32x4 __attribute__((ext_vector_type(4)));
constexpr int BM = 256, BK = 64, HALF = 128, HTB = HALF * BK * 2  , STAGE_BYTES = 8 * HTB, NXCD = 8, WGM = 8;

__host__ __device__ __forceinline__ int lds_byte(int r, int c) { const int st = (r >> 4) * 2 + (c >> 5), rr = r & 15, cc = c & 31, ob = rr * 64 + cc * 2; return st * 1024 + (ob ^ (((ob >> 9) & 1) << 5)); }
__host__ __device__ __forceinline__ void stage_rc(int b, int& R, int& C) { const int st = b / 1024, sb = b % 1024, swz = sb ^ (((sb >> 9) & 1) << 5); R = (st >> 1) * 16 + swz / 64; C = (st & 1) * 32 + (swz % 64) / 2; }
__host__ __device__ __forceinline__ int perm32(int rho) { const int n = rho >> 4, i = rho & 15; return 8 * (i >> 2) + 4 * n + (i & 3); }

struct Unit { int pm, pn; };
struct Gemm { const bf16_t* A; const bf16_t* Bt; int M, N, K; const int* rowmap = nullptr; };

struct StaticOrder {
    int nM, nN, nwg, G, c;
    __host__ __device__ void init(int M, int N, int G_, int c_) { nM = M / BM; nN = N / BM; nwg = nM * nN; G = G_; c = c_; }
    __host__ __device__ bool next(int i, Unit& u) const {
        const long L = (long)i * G + c; if (L >= nwg) return false;
        int wgid = (int)L; { const int q = nwg / NXCD, r = nwg % NXCD, xcd = wgid % NXCD, off = wgid / NXCD; wgid = (xcd < r ? xcd * (q + 1) : r * (q + 1) + (xcd - r) * q) + off; }
        const int nig = WGM * nN, gid = wgid / nig, fm = gid * WGM, gsz = (nM - fm) < WGM ? (nM - fm) : WGM;
        u.pm = fm + ((wgid % nig) % gsz); u.pn = (wgid % nig) / gsz; return true;
    }
    __device__ __forceinline__ void a_ready(const Unit&) const {}
    __device__ __forceinline__ void done(const Unit&) const {}
};


__device__ __forceinline__ unsigned cvt_pk_bf16(float lo, float hi) { unsigned r; asm volatile("v_cvt_pk_bf16_f32 %0, %1, %2" : "=v"(r) : "v"(lo), "v"(hi)); return r; }
__device__ __forceinline__ float fsigm(float x) { return __builtin_amdgcn_rcpf(1.0f + __expf(-x)); }
__device__ __forceinline__ float bflo(unsigned w) { return __uint_as_float(w << 16); }
__device__ __forceinline__ float bfhi(unsigned w) { return __uint_as_float(w & 0xffff0000u); }

struct EpiBf16Store {
    static constexpr bool PERM = true, AFTER_DRAIN = false, MIDK = false;
    bf16_t* O; long ldc;
    __device__ __forceinline__ void operator()(const f32x4 (&acc)[2][2][4][2], const Unit& u, int wr, int wc, int fr, int fq) const {
        const int row0 = u.pm * BM + wr * 64 + fr, col0 = u.pn * BM + wc * 32 + 8 * fq;
#pragma unroll
        for (int ai = 0; ai < 2; ++ai)
#pragma unroll
            for (int m = 0; m < 4; ++m) { bf16_t* rowp = O + (size_t)(row0 + ai * HALF + m * 16) * ldc + col0;
#pragma unroll
                for (int bj = 0; bj < 2; ++bj) { const f32x4 v0 = acc[ai][bj][m][0], v1 = acc[ai][bj][m][1];
                    u32x4 w; w.x = cvt_pk_bf16(v0[0], v0[1]); w.y = cvt_pk_bf16(v0[2], v0[3]); w.z = cvt_pk_bf16(v1[0], v1[1]); w.w = cvt_pk_bf16(v1[2], v1[3]);
                    *(u32x4*)(rowp + bj * HALF) = w; } }
    }
};

struct EpiGate1 {
    static constexpr bool PERM = true, AFTER_DRAIN = false, MIDK = false;
    float* T1; const bf16_t* Pg;
    __device__ __forceinline__ void operator()(const f32x4 (&acc)[2][2][4][2], const Unit& u, int wr, int wc, int fr, int fq) const {
        const int row0 = u.pm * BM + wr * 64 + fr, col0 = u.pn * BM + wc * 32 + 8 * fq;
#pragma unroll
        for (int ai = 0; ai < 2; ++ai)
#pragma unroll
            for (int m = 0; m < 4; ++m) { const size_t row = (size_t)(row0 + ai * HALF + m * 16); const bf16_t* gp = Pg + row * 6144 + col0;
#pragma unroll
                for (int bj = 0; bj < 2; ++bj) { const u32x4 ga = *(const u32x4*)(gp + bj * HALF); const unsigned gw[4] = {ga.x, ga.y, ga.z, ga.w};
                    const f32x4 v0 = acc[ai][bj][m][0], v1 = acc[ai][bj][m][1];
                    f32x4 o0, o1;
                    o0[0] = v0[0] * fsigm(bflo(gw[0])); o0[1] = v0[1] * fsigm(bfhi(gw[0])); o0[2] = v0[2] * fsigm(bflo(gw[1])); o0[3] = v0[3] * fsigm(bfhi(gw[1]));
                    o1[0] = v1[0] * fsigm(bflo(gw[2])); o1[1] = v1[1] * fsigm(bfhi(gw[2])); o1[2] = v1[2] * fsigm(bflo(gw[3])); o1[3] = v1[3] * fsigm(bfhi(gw[3]));
                    float* tp = T1 + row * 1024 + col0 + bj * HALF; *(f32x4*)tp = o0; *(f32x4*)(tp + 4) = o1; } }
    }
};
struct EpiGate2 {
    static constexpr bool PERM = true, AFTER_DRAIN = false, MIDK = false;
    const float* T1; bf16_t* O; const bf16_t* Pg;
    __device__ __forceinline__ void operator()(const f32x4 (&acc)[2][2][4][2], const Unit& u, int wr, int wc, int fr, int fq) const {
        const int row0 = u.pm * BM + wr * 64 + fr, col0 = u.pn * BM + wc * 32 + 8 * fq;
#pragma unroll
        for (int ai = 0; ai < 2; ++ai)
#pragma unroll
            for (int m = 0; m < 4; ++m) { const size_t row = (size_t)(row0 + ai * HALF + m * 16); const bf16_t* gp = Pg + row * 6144 + col0 + 1024;
#pragma unroll
                for (int bj = 0; bj < 2; ++bj) { const u32x4 gb = *(const u32x4*)(gp + bj * HALF); const unsigned gw[4] = {gb.x, gb.y, gb.z, gb.w};
                    const float* tp = T1 + row * 1024 + col0 + bj * HALF; const f32x4 t0 = *(const f32x4*)tp, t1 = *(const f32x4*)(tp + 4);
                    const f32x4 v0 = acc[ai][bj][m][0], v1 = acc[ai][bj][m][1];
                    u32x4 w; w.x = cvt_pk_bf16(t0[0] + v0[0] * fsigm(bflo(gw[0])), t0[1] + v0[1] * fsigm(bfhi(gw[0]))); w.y = cvt_pk_bf16(t0[2] + v0[2] * fsigm(bflo(gw[1])), t0[3] + v0[3] * fsigm(bfhi(gw[1])));
                    w.z = cvt_pk_bf16(t1[0] + v1[0] * fsigm(bflo(gw[2])), t1[1] + v1[1] * fsigm(bfhi(gw[2]))); w.w = cvt_pk_bf16(t1[2] + v1[2] * fsigm(bflo(gw[3])), t1[3] + v1[3] * fsigm(bfhi(gw[3])));
                    *(u32x4*)(O + row * 1024 + col0 + bj * HALF) = w; } }
    }
};
struct EpiX1 {
    static constexpr bool PERM = false, AFTER_DRAIN = false, MIDK = false;
    const float* X; float* O; const float* gt1; const float* PER; const float* PEC;
    __device__ __forceinline__ void operator()(const f32x4 (&acc)[2][2][4][2], const Unit& u, int wr, int wc, int fr, int fq) const {
        const int row0 = u.pm * BM + wr * 64 + fr, col0 = u.pn * BM + wc * 32 + 4 * fq;
#pragma unroll
        for (int ai = 0; ai < 2; ++ai)
#pragma unroll
            for (int m = 0; m < 4; ++m) { const int row = row0 + ai * HALF + m * 16, b = row >> 13, t = row & 8191;
#pragma unroll
                for (int bj = 0; bj < 2; ++bj)
#pragma unroll
                    for (int n = 0; n < 2; ++n) { const int col = col0 + bj * HALF + n * 16;
                        const f32x4 xv = *(const f32x4*)(X + (size_t)row * 1024 + col), gv = *(const f32x4*)(gt1 + b * 6144 + col);
                        const f32x4 pe = col < 512 ? *(const f32x4*)(PER + (size_t)(t >> 6) * 512 + col) : *(const f32x4*)(PEC + (size_t)(t & 63) * 512 + col - 512);
                        *(f32x4*)(O + (size_t)row * 1024 + col) = xv + pe + gv * acc[ai][bj][m][n]; } }
    }
};
struct EpiHid {
    static constexpr bool PERM = true, AFTER_DRAIN = false, MIDK = false;
    bf16_t* H; const float* slot_w;
    __device__ __forceinline__ void operator()(const f32x4 (&acc)[2][2][4][2], const Unit& u, int wr, int wc, int fr, int fq) const {
        const int row0 = u.pm * BM + wr * 64 + fr, col0 = (u.pn & 3) * HALF + wc * 32 + 8 * fq;
#pragma unroll
        for (int ai = 0; ai < 2; ++ai)
#pragma unroll
            for (int m = 0; m < 4; ++m) { const size_t row = (size_t)(row0 + ai * HALF + m * 16); const float ws = slot_w[row];
                float h[8];
#pragma unroll
                for (int q = 0; q < 8; ++q) { const float g = acc[ai][0][m][q >> 2][q & 3], uu = acc[ai][1][m][q >> 2][q & 3]; h[q] = g * fsigm(g) * uu * ws; }
                u32x4 w; w.x = cvt_pk_bf16(h[0], h[1]); w.y = cvt_pk_bf16(h[2], h[3]); w.z = cvt_pk_bf16(h[4], h[5]); w.w = cvt_pk_bf16(h[6], h[7]);
                *(u32x4*)(H + row * 512 + col0) = w; }
    }
};
struct EpiY {
    static constexpr bool PERM = true, AFTER_DRAIN = false, MIDK = false;
    bf16_t* O;
    __device__ __forceinline__ void operator()(const f32x4 (&acc)[2][2][4][2], const Unit& u, int wr, int wc, int fr, int fq) const {
        const int row0 = u.pm * BM + wr * 64 + fr, col0 = (u.pn & 3) * BM + wc * 32 + 8 * fq;
#pragma unroll
        for (int ai = 0; ai < 2; ++ai)
#pragma unroll
            for (int m = 0; m < 4; ++m) { bf16_t* rowp = O + (size_t)(row0 + ai * HALF + m * 16) * 1024 + col0;
#pragma unroll
                for (int bj = 0; bj < 2; ++bj) { const f32x4 v0 = acc[ai][bj][m][0], v1 = acc[ai][bj][m][1];
                    u32x4 w; w.x = cvt_pk_bf16(v0[0], v0[1]); w.y = cvt_pk_bf16(v0[2], v0[3]); w.z = cvt_pk_bf16(v1[0], v1[1]); w.w = cvt_pk_bf16(v1[2], v1[3]);
                    *(u32x4*)(rowp + bj * HALF) = w; } }
    }
};
struct MoeOrder {
    const int* tile_e; int ntiles, G, c;
    __device__ bool next(int i, Unit& u) const { const int Lx = i * G + c; if (Lx >= ntiles * 4) return false; u.pm = Lx >> 2; u.pn = tile_e[u.pm] * 4 + (Lx & 3); return true; }
    __device__ __forceinline__ void a_ready(const Unit&) const {}
    __device__ __forceinline__ void done(const Unit&) const {}
};

struct EpiMergeScale {
    static constexpr bool PERM = true, AFTER_DRAIN = true, MIDK = false;
    const bf16_t* Pg;
    __device__ __forceinline__ void fused(f32x4 (&acc)[2][2][4][2], const Unit& u, int wr, int wc, int fr, int fq, PG8_LAS unsigned char*, int, int) const {
        const int row0 = u.pm * BM + wr * 64 + fr, col0 = u.pn * BM + wc * 32 + 8 * fq;
#pragma unroll
        for (int ai = 0; ai < 2; ++ai)
#pragma unroll
            for (int m = 0; m < 4; ++m) { const bf16_t* gp = Pg + (size_t)(row0 + ai * HALF + m * 16) * 6144 + col0;
#pragma unroll
                for (int bj = 0; bj < 2; ++bj) { const u32x4 ga = *(const u32x4*)(gp + bj * HALF), gb = *(const u32x4*)(gp + 1024 + bj * HALF);
                    const unsigned gaw[4] = {ga.x, ga.y, ga.z, ga.w}, gbw[4] = {gb.x, gb.y, gb.z, gb.w};
#pragma unroll
                    for (int q = 0; q < 4; ++q) { const int n = q >> 1, e0 = (q & 1) * 2;
                        const float r0 = (1.0f + __expf(-bflo(gbw[q]))) * __builtin_amdgcn_rcpf(1.0f + __expf(-bflo(gaw[q])));
                        const float r1 = (1.0f + __expf(-bfhi(gbw[q]))) * __builtin_amdgcn_rcpf(1.0f + __expf(-bfhi(gaw[q])));
                        acc[ai][bj][m][n][e0] *= r0; acc[ai][bj][m][n][e0 + 1] *= r1; } } }
    }
};
struct EpiMergeOut {
    static constexpr bool PERM = true, AFTER_DRAIN = false, MIDK = false;
    bf16_t* O; const bf16_t* Pg;
    __device__ __forceinline__ void operator()(const f32x4 (&acc)[2][2][4][2], const Unit& u, int wr, int wc, int fr, int fq) const {
        const int row0 = u.pm * BM + wr * 64 + fr, col0 = u.pn * BM + wc * 32 + 8 * fq;
#pragma unroll
        for (int ai = 0; ai < 2; ++ai)
#pragma unroll
            for (int m = 0; m < 4; ++m) { const size_t row = (size_t)(row0 + ai * HALF + m * 16); const bf16_t* gp = Pg + row * 6144 + col0 + 1024;
#pragma unroll
                for (int bj = 0; bj < 2; ++bj) { const u32x4 gb = *(const u32x4*)(gp + bj * HALF); const unsigned gw[4] = {gb.x, gb.y, gb.z, gb.w};
                    const f32x4 v0 = acc[ai][bj][m][0], v1 = acc[ai][bj][m][1];
                    u32x4 w; w.x = cvt_pk_bf16(v0[0] * fsigm(bflo(gw[0])), v0[1] * fsigm(bfhi(gw[0]))); w.y = cvt_pk_bf16(v0[2] * fsigm(bflo(gw[1])), v0[3] * fsigm(bfhi(gw[1])));
                    w.z = cvt_pk_bf16(v1[0] * fsigm(bflo(gw[2])), v1[1] * fsigm(bfhi(gw[2]))); w.w = cvt_pk_bf16(v1[2] * fsigm(bflo(gw[3])), v1[3] * fsigm(bfhi(gw[3])));
                    *(u32x4*)(O + row * 1024 + col0 + bj * HALF) = w; } }
    }
};

template <class Epi, class Sched, bool ALIGN_EPI = false, bool SP2 = false, bool ZERO_ACC = true, bool GATHER = false>
__device__ __forceinline__ void gemm_phase_acc(PG8_LAS unsigned char* lds, const Gemm g, const Sched& S, const Epi& E, f32x4 (&acc)[2][2][4][2]) {
    const int tid = threadIdx.x, wid = __builtin_amdgcn_readfirstlane(tid >> 6), lane = tid & 63, wr = wid >> 2, wc = wid & 3, fr = lane & 15, fq = lane >> 4;
    const int K = g.K, nt = K / BK;
    unsigned voffB[2], vgC0[2], vgC1[2], vgN0[2], vgN1[2]; int RA[2], CA[2];
#pragma unroll
    for (int i = 0; i < 2; ++i) { int R, C; stage_rc(tid * 16 + i * 8192, R, C); const int Rb = Epi::PERM ? ((R & ~31) + perm32(R & 31)) : R;
        RA[i] = R; CA[i] = C; voffB[i] = (unsigned)(Rb * K + C) * 2u; }
#define PG8_SETVG(v0_, v1_, pm_) do { _Pragma("unroll") for (int _i = 0; _i < 2; ++_i) { const int r0_ = (pm_) * BM + RA[_i], r1_ = r0_ + HALF; \
        const unsigned ro0_ = GATHER ? (unsigned)g.rowmap[r0_] : (unsigned)r0_, ro1_ = GATHER ? (unsigned)g.rowmap[r1_] : (unsigned)r1_; \
        v0_[_i] = (ro0_ * (unsigned)K + (unsigned)CA[_i]) * 2u; v1_[_i] = (ro1_ * (unsigned)K + (unsigned)CA[_i]) * 2u; } } while (0)
    const size_t kstep = (size_t)(BK * 2);
    const size_t hstep = (size_t)HALF * K * 2;
    const size_t tstep = 2 * hstep;
    const unsigned ldsw = (unsigned)wid * 1024u;
    const int aoff = lds_byte(wr * 64 + fr, fq * 8), boff = lds_byte(wc * 32 + fr, fq * 8);
#define PG8_SA(b, h) (((b) * 2 + (h)) * HTB)
#define PG8_SB(b, h) ((4 + (b) * 2 + (h)) * HTB)
#define PG8_STAGE(bufoff, gbase, voff) do { _Pragma("unroll") for (int _i = 0; _i < 2; ++_i) \
        __builtin_amdgcn_global_load_lds((const unsigned*)((const char*)(gbase) + (voff)[_i]), (PG8_LAS unsigned*)(lds + (bufoff) + ldsw + _i * 8192), 16, 0, 0); } while (0)
#define PG8_LDA(dst, b, h) do { _Pragma("unroll") for (int m = 0; m < 4; ++m) _Pragma("unroll") for (int k = 0; k < 2; ++k) dst[m][k] = *(const PG8_LAS bf16x8*)(lds + PG8_SA(b, h) + aoff + m * 2048 + k * 1024); } while (0)
#define PG8_LDB(dst, b, h) do { _Pragma("unroll") for (int n = 0; n < 2; ++n) _Pragma("unroll") for (int k = 0; k < 2; ++k) dst[n][k] = *(const PG8_LAS bf16x8*)(lds + PG8_SB(b, h) + boff + n * 2048 + k * 1024); } while (0)
#define PG8_MMA(ai, bj, At, Bt) do { __builtin_amdgcn_s_setprio(1); _Pragma("unroll") for (int m = 0; m < 4; ++m) _Pragma("unroll") for (int n = 0; n < 2; ++n) _Pragma("unroll") for (int k = 0; k < 2; ++k) \
        acc[ai][bj][m][n] = __builtin_amdgcn_mfma_f32_16x16x32_bf16(Bt[n][k], At[m][k], acc[ai][bj][m][n], 0, 0, 0); __builtin_amdgcn_s_setprio(0); } while (0)
#define PG8_WAIT_V(n) asm volatile("s_waitcnt vmcnt(" #n ")" ::: "memory")
#define PG8_WAIT_L(n) asm volatile("s_waitcnt lgkmcnt(" #n ")" ::: "memory")
#define PG8_BAR __builtin_amdgcn_s_barrier()
#define PG8_SCHED __builtin_amdgcn_sched_barrier(0)
    Unit cur, nxt; int ui = 0;
    if (!S.next(0, cur)) return;
    if constexpr (ZERO_ACC) {
#pragma unroll
    for (int a = 0; a < 2; ++a)
#pragma unroll
        for (int b = 0; b < 2; ++b)
#pragma unroll
            for (int m = 0; m < 4; ++m)
#pragma unroll
                for (int n = 0; n < 2; ++n) acc[a][b][m][n] = (f32x4){0.f, 0.f, 0.f, 0.f};
    }
    bf16x8 At[4][2], B0[2][2], B1[2][2];
    const char* const gA = (const char*)g.A; const char* cB = (const char*)g.Bt + (size_t)cur.pn * tstep;
    S.a_ready(cur);
    PG8_SETVG(vgC0, vgC1, cur.pm);
    if constexpr (SP2) {
        PG8_STAGE(PG8_SB(0, 0), cB, voffB); PG8_STAGE(PG8_SB(0, 1), cB + hstep, voffB); PG8_STAGE(PG8_SA(0, 0), gA, vgC0); PG8_STAGE(PG8_SA(0, 1), gA, vgC1);
        if (wr == 1) PG8_BAR;
        PG8_WAIT_V(2); PG8_BAR;
        PG8_STAGE(PG8_SB(1, 0), cB + kstep, voffB); PG8_STAGE(PG8_SA(1, 0), gA + kstep, vgC0); PG8_STAGE(PG8_SB(1, 1), cB + hstep + kstep, voffB);
        PG8_WAIT_V(6); PG8_BAR;
    } else {
        PG8_STAGE(PG8_SB(0, 0), cB, voffB); PG8_STAGE(PG8_SA(0, 0), gA, vgC0); PG8_STAGE(PG8_SB(0, 1), cB + hstep, voffB); PG8_STAGE(PG8_SA(0, 1), gA, vgC1);
        if (wr == 1) PG8_BAR;
        PG8_WAIT_V(4); PG8_BAR;
        PG8_STAGE(PG8_SB(1, 0), cB + kstep, voffB); PG8_STAGE(PG8_SA(1, 0), gA + kstep, vgC0); PG8_STAGE(PG8_SB(1, 1), cB + hstep + kstep, voffB);
        PG8_WAIT_V(6); PG8_BAR;
    }
    for (;;) {
        const bool has_next = S.next(ui + 1, nxt);
        const char* nB = has_next ? (const char*)g.Bt + (size_t)nxt.pn * tstep : cB;
        if (has_next) PG8_SETVG(vgN0, vgN1, nxt.pm);
        for (int t = 0; t < nt; t += 2) {
            const bool last = (t == nt - 2);
            const char* a1 = gA + (size_t)(t + 1) * kstep;
            const bool selN = last && has_next;
            const char* a2 = last ? gA : gA + (size_t)(t + 2) * kstep; const char* b2 = last ? nB : cB + (size_t)(t + 2) * kstep;
            const char* a3 = a2 + kstep; const char* b3 = b2 + kstep;
            unsigned v2_0[2], v2_1[2];
#pragma unroll
            for (int _i = 0; _i < 2; ++_i) { v2_0[_i] = selN ? vgN0[_i] : vgC0[_i]; v2_1[_i] = selN ? vgN1[_i] : vgC1[_i]; }
            if (last && has_next) S.a_ready(nxt);
            if constexpr (SP2) {
            PG8_LDB(B0, 0, 0); PG8_LDB(B1, 0, 1); PG8_SCHED; PG8_LDA(At, 0, 0); PG8_STAGE(PG8_SA(1, 1), a1, vgC1);
            PG8_WAIT_V(8); PG8_WAIT_L(0); PG8_BAR; PG8_MMA(0, 0, At, B0); PG8_MMA(0, 1, At, B1); PG8_BAR; PG8_SCHED;
            PG8_LDA(At, 0, 1); PG8_STAGE(PG8_SB(0, 0), b2, voffB); PG8_STAGE(PG8_SB(0, 1), b2 + hstep, voffB); PG8_STAGE(PG8_SA(0, 0), a2, v2_0);
            PG8_WAIT_V(8); PG8_WAIT_L(0); PG8_BAR; PG8_MMA(1, 0, At, B0); PG8_MMA(1, 1, At, B1); PG8_BAR; PG8_SCHED;
            PG8_LDB(B0, 1, 0); PG8_LDB(B1, 1, 1); PG8_SCHED; PG8_LDA(At, 1, 0); PG8_STAGE(PG8_SA(0, 1), a2, v2_1);
            PG8_WAIT_V(8); PG8_WAIT_L(0); PG8_BAR; PG8_MMA(0, 0, At, B0); PG8_MMA(0, 1, At, B1); PG8_BAR; PG8_SCHED;
            PG8_LDA(At, 1, 1); PG8_STAGE(PG8_SB(1, 0), b3, voffB); PG8_STAGE(PG8_SB(1, 1), b3 + hstep, voffB); PG8_STAGE(PG8_SA(1, 0), a3, v2_0);
            PG8_WAIT_V(8); PG8_WAIT_L(0); PG8_BAR; PG8_MMA(1, 0, At, B0); PG8_MMA(1, 1, At, B1); PG8_BAR; PG8_SCHED;
            } else {
            PG8_LDB(B0, 0, 0); PG8_SCHED; PG8_LDA(At, 0, 0); PG8_STAGE(PG8_SA(1, 1), a1, vgC1);
            PG8_WAIT_L(8); PG8_BAR; PG8_WAIT_L(0); PG8_MMA(0, 0, At, B0); PG8_BAR; PG8_SCHED;
            PG8_LDB(B1, 0, 1); PG8_STAGE(PG8_SB(0, 0), b2, voffB);
            PG8_BAR; PG8_WAIT_L(0); PG8_MMA(0, 1, At, B1); PG8_BAR;
            PG8_LDA(At, 0, 1); PG8_STAGE(PG8_SA(0, 0), a2, v2_0);
            PG8_BAR; PG8_WAIT_L(0); PG8_MMA(1, 0, At, B0); PG8_BAR; PG8_SCHED;
            PG8_STAGE(PG8_SB(0, 1), b2 + hstep, voffB);
            PG8_WAIT_V(6); PG8_BAR; PG8_MMA(1, 1, At, B1); PG8_BAR;
            PG8_LDB(B0, 1, 0); PG8_SCHED; PG8_LDA(At, 1, 0); PG8_STAGE(PG8_SA(0, 1), a2, v2_1);
            PG8_WAIT_L(8); PG8_BAR; PG8_WAIT_L(0); PG8_MMA(0, 0, At, B0); PG8_BAR; PG8_SCHED;
            PG8_LDB(B1, 1, 1); PG8_STAGE(PG8_SB(1, 0), b3, voffB);
            PG8_BAR; PG8_WAIT_L(0); PG8_MMA(0, 1, At, B1); PG8_BAR;
            PG8_LDA(At, 1, 1); PG8_STAGE(PG8_SA(1, 0), a3, v2_0);
            PG8_BAR; PG8_WAIT_L(0); PG8_MMA(1, 0, At, B0); PG8_BAR; PG8_SCHED;
            PG8_STAGE(PG8_SB(1, 1), b3 + hstep, voffB);
            PG8_WAIT_V(6); PG8_BAR; PG8_MMA(1, 1, At, B1); PG8_BAR;
            }
        }
        if constexpr (ALIGN_EPI) { if (wr == 0) PG8_BAR; }
        if constexpr (!Epi::AFTER_DRAIN) { E(acc, cur, wr, wc, fr, fq); S.done(cur); }
        if (!has_next) break;
#pragma unroll
        for (int a = 0; a < 2; ++a)
#pragma unroll
            for (int b = 0; b < 2; ++b)
#pragma unroll
                for (int m = 0; m < 4; ++m)
#pragma unroll
                    for (int n = 0; n < 2; ++n) acc[a][b][m][n] = (f32x4){0.f, 0.f, 0.f, 0.f};
        cur = nxt; cB = nB; ++ui;
#pragma unroll
        for (int _i = 0; _i < 2; ++_i) { vgC0[_i] = vgN0[_i]; vgC1[_i] = vgN1[_i]; }
        if constexpr (ALIGN_EPI) { if (wr == 1) PG8_BAR; }
    }
    PG8_WAIT_V(0);
    if constexpr (!ALIGN_EPI) { if (wr == 0) PG8_BAR; }
    PG8_BAR;
    if constexpr (Epi::AFTER_DRAIN) { E.fused(acc, cur, wr, wc, fr, fq, lds, wid, lane); S.done(cur); }
#undef PG8_SA
#undef PG8_SB
#undef PG8_STAGE
#undef PG8_SETVG
#undef PG8_LDA
#undef PG8_LDB
#undef PG8_MMA
#undef PG8_WAIT_V
#undef PG8_WAIT_L
#undef PG8_BAR
#undef PG8_SCHED
}
template <class Epi, class Sched, bool ALIGN_EPI = false, bool SP2 = false>
__device__ __forceinline__ void gemm_phase(PG8_LAS unsigned char* lds, const Gemm g, const Sched& S, const Epi& E) {
    f32x4 acc[2][2][4][2];
    gemm_phase_acc<Epi, Sched, ALIGN_EPI, SP2, true>(lds, g, S, E, acc);
}
}

#define GAS __attribute__((address_space(1)))
#define LAS __attribute__((address_space(3)))
typedef unsigned short bf16;
typedef unsigned v4u __attribute__((ext_vector_type(4)));
typedef float f32x4 __attribute__((ext_vector_type(4)));
typedef short bf16x8 __attribute__((ext_vector_type(8)));
typedef GAS unsigned gu32;
typedef GAS unsigned long long gu64;
#define RLX_AGENT __ATOMIC_RELAXED, __HIP_MEMORY_SCOPE_AGENT
#define LDS_WAIT() asm volatile("s_waitcnt lgkmcnt(0)" ::: "memory")
#define VM_WAIT() asm volatile("s_waitcnt vmcnt(0)" ::: "memory")
__device__ __forceinline__ unsigned long long rt() { return __builtin_amdgcn_s_memrealtime(); }
typedef __bf16 bf16x2_t __attribute__((ext_vector_type(2)));
__device__ __forceinline__ unsigned pk2(float lo, float hi) { bf16x2_t v; v.x = (__bf16)lo; v.y = (__bf16)hi; return __builtin_bit_cast(unsigned, v); }
__device__ __forceinline__ unsigned f2bf(float f) { return pk2(f, 0.f) & 0xffffu; }

#define XB_TMO      128
#define XB_XCNT(j)  (256  + 64 * (j))
#define XB_XSUB(j)  (1280 + 64 * (j))
#define XB_XGEN(j)  (2304 + 64 * (j))
#define XB_TOP      3328
#define XB_TOPGEN   3392
#define XCD_BAR_WORDS 3456
#define XB_SPIN_CAP (1u << 18)

__device__ __forceinline__ unsigned xb_ld(unsigned* p)              { return __hip_atomic_load(p, __ATOMIC_RELAXED, __HIP_MEMORY_SCOPE_AGENT); }
__device__ __forceinline__ unsigned xb_add(unsigned* p, unsigned v) { return __hip_atomic_fetch_add(p, v, __ATOMIC_RELAXED, __HIP_MEMORY_SCOPE_AGENT); }
__device__ __forceinline__ unsigned xb_xcc_id() { return (unsigned)__builtin_amdgcn_s_getreg((3 << 11) | 20) & 0xFu; }
#define XB_SPIN(cond, bar) do { unsigned _sp = 0; while (cond) { __builtin_amdgcn_s_sleep(1); \
    if ((++_sp & 255u) == 0u) { if (xb_ld(&(bar)[XB_TMO])) break; if (_sp > XB_SPIN_CAP) { atomicAdd(&(bar)[XB_TMO], 1u); break; } } } } while (0)

struct XcdBarrier {
    unsigned* bar; unsigned x;
    volatile LAS unsigned* st;
};

__device__ __forceinline__ XcdBarrier xcd_barrier_post(unsigned* bar, volatile LAS unsigned* st) {
    XcdBarrier b; b.bar = bar; b.x = xb_xcc_id(); b.st = st;
    if (threadIdx.x == 0) (void)xb_add(&bar[XB_XCNT(b.x)], 1u);
    return b;
}
__device__ __forceinline__ void xcd_barrier_complete(unsigned* bar, unsigned x, unsigned& nloc, unsigned& nx) {
    const unsigned G = gridDim.x * gridDim.y * gridDim.z;
    unsigned sum, cnt, mine, sp = 0u;
    for (;;) {
        sum = 0u; cnt = 0u; mine = 0u;
#pragma unroll
        for (unsigned j = 0; j < 16; ++j) { const unsigned c = xb_ld(&bar[XB_XCNT(j)]); sum += c; cnt += (c > 0u) ? 1u : 0u; mine = (j == x) ? c : mine; }
        if (sum == G) break;
        __builtin_amdgcn_s_sleep(1);
        if ((++sp & 255u) == 0u) { if (xb_ld(&bar[XB_TMO])) break; if (sp > XB_SPIN_CAP) { atomicAdd(&bar[XB_TMO], 1u); break; } }
    }
    nloc = mine > 0u ? mine : 1u; nx = cnt > 0u ? cnt : 1u;
}

__device__ __forceinline__ void xcd_barrier(const XcdBarrier& b) {
    asm volatile("s_waitcnt vmcnt(0)" ::: "memory");
    __syncthreads();
    if (threadIdx.x == 0) {
        unsigned* bar = b.bar;
        __builtin_amdgcn_s_waitcnt(0);
        unsigned nloc = b.st[0], nx = b.st[1];
        if (nloc == 0u) { xcd_barrier_complete(bar, b.x, nloc, nx); b.st[0] = nloc; b.st[1] = nx; }
        const unsigned old = xb_add(&bar[XB_XSUB(b.x)], 1u);
        const unsigned gen = old / nloc;
        if (old + 1u == (gen + 1u) * nloc) {
            __builtin_amdgcn_fence(__ATOMIC_RELEASE, "agent");
            asm volatile("s_waitcnt vmcnt(0)" ::: "memory");
            const unsigned og = xb_add(&bar[XB_TOP], 1u);
            const unsigned tg = og / nx;
            if (og + 1u == (tg + 1u) * nx) xb_add(&bar[XB_TOPGEN], 1u);
            else XB_SPIN(xb_ld(&bar[XB_TOPGEN]) == tg, bar);
            __builtin_amdgcn_fence(__ATOMIC_ACQUIRE, "agent");
            xb_add(&bar[XB_XGEN(b.x)], 1u);
            asm volatile("s_waitcnt vmcnt(0)" ::: "memory");
        } else {
            XB_SPIN(xb_ld(&bar[XB_XGEN(b.x)]) == gen, bar);
            __builtin_amdgcn_fence(__ATOMIC_ACQUIRE, "agent");
            asm volatile("s_waitcnt vmcnt(0)" ::: "memory");
        }
    }
    __syncthreads();
}

namespace mk {
using pg8::bf16_t;
constexpr int NWAVES = 8, NTHR = 512;
constexpr int NB = 2, L = 8192, D = 1024, T = NB * L, CTX = 256, TC = NB * CTX, MR = T + TC;
constexpr int INW = 6144;
constexpr int C_Q = 0, C_ZF = 512, C_ZB = 1024, C_V = 1536, C_G = 2048, C_HY = 2560, C_GL = 4096;
constexpr float EPS = 1e-6f;
constexpr size_t MiB = 1u << 20;
constexpr size_t WS_CTL = 0, CTL_ZERO_BYTES = 64 * 1024;
constexpr size_t WS_MODP = 128 * 1024;
constexpr size_t WS_MOD = 1 * MiB;
constexpr size_t WS_LB = 1 * MiB + 96 * 1024;
constexpr size_t WS_PER = 1 * MiB + 128 * 1024;
constexpr size_t WS_PEC = 1 * MiB + 384 * 1024;
constexpr size_t WS_WRT = 1 * MiB + 512 * 1024;
constexpr size_t WS_WIN_T = 2 * MiB;
constexpr size_t WS_WA_T = 14 * MiB, WS_WB_T = 15 * MiB;
constexpr size_t WS_WO_T = 16 * MiB;
constexpr size_t WS_P = 18 * MiB;
constexpr size_t WS_HX = 216 * MiB;
constexpr size_t WS_GR = 249 * MiB;
constexpr size_t WS_UT = 265 * MiB;
constexpr size_t WS_YT = 281 * MiB;
constexpr size_t WS_END = 300 * MiB;
constexpr int CW_BAR = 1024;
constexpr int LDS_BYTES = 163840, MISC_OFF = LDS_BYTES - 256;

struct Args { const float* in[32]; float* out; unsigned char* ws; int ph_lo, ph_hi; };

__device__ __forceinline__ float bf2f_(bf16_t v) { return __uint_as_float(((unsigned)v) << 16); }
__device__ __forceinline__ float sigm(float x) { return 1.0f / (1.0f + __expf(-x)); }
__device__ __forceinline__ float silu(float x) { return x * sigm(x); }
#define DPP_ADD(v_, ctrl_, rmask_) v_ += __int_as_float(__builtin_amdgcn_update_dpp(0, __float_as_int(v_), ctrl_, rmask_, 0xf, false))
__device__ __forceinline__ float row16_sum(float v) {
    DPP_ADD(v, 0xB1, 0xf); DPP_ADD(v, 0x4E, 0xf); DPP_ADD(v, 0x124, 0xf); DPP_ADD(v, 0x128, 0xf);
    return v;
}
__device__ __forceinline__ float wave_sum(float v) {
    v = row16_sum(v);
    DPP_ADD(v, 0x142, 0xa);
    DPP_ADD(v, 0x143, 0xc);
    return __int_as_float(__builtin_amdgcn_readlane(__float_as_int(v), 63));
}

struct Frame {
    LAS unsigned char* lds;
    int tid, lane, wave, vcu, G, gw, NGW;
    const float* const* in; float* out; unsigned char* ws;
};

#ifndef MK_REP0A
#define MK_REP0A 0
#endif
#ifndef MK_REP0B
#define MK_REP0B 0
#endif
__device__ __forceinline__ void p0_transpose_item(const float* W, int N, bf16_t* WT, int ldk, int koff, LAS float* scr, int item, int lane) {
    const int nblk = N / 32, kb = item / nblk, nb = item % nblk, k0 = 64 * kb, n0 = 32 * nb;
    float tv[32];
#pragma unroll
    for (int i = 0; i < 32; ++i) tv[i] = W[(size_t)(k0 + 2 * i + (lane >> 5)) * N + n0 + (lane & 31)];
#pragma unroll
    for (int i = 0; i < 32; ++i) scr[(2 * i + (lane >> 5)) * 33 + (lane & 31)] = tv[i];
    LDS_WAIT(); asm volatile("" ::: "memory");
    const int c = lane & 7;
#pragma unroll
    for (int j = 0; j < 4; ++j) { const int n = (lane >> 3) + 8 * j; const LAS float* s = scr + (8 * c) * 33 + n;
        v4u o; o.x = pk2(s[0 * 33], s[1 * 33]); o.y = pk2(s[2 * 33], s[3 * 33]); o.z = pk2(s[4 * 33], s[5 * 33]); o.w = pk2(s[6 * 33], s[7 * 33]);
        *(GAS v4u*)(WT + (size_t)(n0 + n) * ldk + koff + k0 + 8 * c) = o; }
    LDS_WAIT(); asm volatile("" ::: "memory");
}
__device__ __forceinline__ void p0_filter_item(Frame& F, int item) {
    const float* w1 = F.in[13]; const float* b1 = F.in[14]; const float* fr1 = F.in[15]; const float* w2 = F.in[16]; const float* b2 = F.in[17]; const float* fr2 = F.in[18];
    const float* w3 = F.in[19]; const float* hyd = F.in[20];
    bf16_t* GR = (bf16_t*)(F.ws + WS_GR);
    LAS float* zs = (LAS float*)F.lds;
    LAS float* h1s = zs + 33 * 36;
    LAS float* h2s = h1s + 33 * 64;
    const int i0 = item * 32, tid = F.tid;
    for (int e = tid; e < 33 * 33; e += NTHR) {
        const int p = e / 33, j = e % 33, i = i0 + p;
        float v;
        if (j == 0) v = (float)i / 8191.0f;
        else { const int band = (j - 1) & 15; const float fb = 1e-4f + (float)band * ((15.0f - 1e-4f) / 15.0f);
               const float ang = (6.283185307179586f * (float)i / 8192.0f) * fb; v = (j <= 16) ? cosf(ang) : -sinf(ang); }
        zs[p * 36 + j] = v;
    }
    __syncthreads();
    for (int e = tid; e < 33 * 64; e += NTHR) { const int p = e >> 6, j = e & 63; float a = b1[j];
        for (int m = 0; m < 33; ++m) a += zs[p * 36 + m] * w1[m * 64 + j];
        h1s[p * 64 + j] = sinf(fr1[j] * a); }
    __syncthreads();
    for (int e = tid; e < 33 * 64; e += NTHR) { const int p = e >> 6, j = e & 63; float a = b2[j];
        for (int m = 0; m < 64; ++m) a += h1s[p * 64 + m] * w2[m * 64 + j];
        h2s[j * 36 + p] = sinf(fr2[j] * a); }
    __syncthreads();
    float af[33], ab[33];
#pragma unroll
    for (int p = 0; p < 33; ++p) { af[p] = 0.f; ab[p] = 0.f; }
    for (int m0 = 0; m0 < 64; m0 += 8) {
        float wa[8], wb[8];
#pragma unroll
        for (int mm = 0; mm < 8; ++mm) { wa[mm] = w3[(m0 + mm) * 1024 + tid]; wb[mm] = w3[(m0 + mm) * 1024 + 512 + tid]; }
#pragma unroll
        for (int mm = 0; mm < 8; ++mm) { const int m = m0 + mm;
#pragma unroll
            for (int p4 = 0; p4 < 32; p4 += 4) { const f32x4 h = *(const LAS f32x4*)(h2s + m * 36 + p4);
#pragma unroll
                for (int q = 0; q < 4; ++q) { af[p4 + q] += h[q] * wa[mm]; ab[p4 + q] += h[q] * wb[mm]; } }
            const float hl = h2s[m * 36 + 32]; af[32] += hl * wa[mm]; ab[32] += hl * wb[mm]; }
    }
    const float la = __logf(0.01f) / 1.5f, lbb = __logf(0.01f) / 0.3f;
    const float delta = fabsf(la + (float)tid * ((lbb - la) / 511.0f));
    const float dsk = hyd[tid];
    {
        unsigned w[16];
#pragma unroll
        for (int e = 0; e < 32; e += 2) {
            const int p0 = 31 - e, p1 = 30 - e;
            float v0 = af[p0] * __expf(-((float)(i0 + p0) / 8191.0f) * delta), v1 = af[p1] * __expf(-((float)(i0 + p1) / 8191.0f) * delta);
            if (i0 + p0 == 0) v0 += dsk; if (i0 + p1 == 0) v1 += dsk;
            w[e >> 1] = pk2(v0, v1);
        }
        GAS v4u* dst = (GAS v4u*)(GR + (size_t)tid * 16384 + 8160 - i0);
#pragma unroll
        for (int q = 0; q < 4; ++q) { v4u o; o.x = w[4 * q]; o.y = w[4 * q + 1]; o.z = w[4 * q + 2]; o.w = w[4 * q + 3]; dst[q] = o; }
    }
    {
        unsigned w[16];
#pragma unroll
        for (int e = 0; e < 32; e += 2) {
            const int p0 = e + 1, p1 = e + 2;
            float v0 = ab[p0] * __expf(-((float)(i0 + p0) / 8191.0f) * delta), v1 = ab[p1] * __expf(-((float)(i0 + p1) / 8191.0f) * delta);
            if (i0 + p0 >= L) v0 = 0.f; if (i0 + p1 >= L) v1 = 0.f;
            w[e >> 1] = pk2(v0, v1);
        }
        GAS v4u* dst = (GAS v4u*)(GR + (size_t)tid * 16384 + 8192 + i0);
#pragma unroll
        for (int q = 0; q < 4; ++q) { v4u o; o.x = w[4 * q]; o.y = w[4 * q + 1]; o.z = w[4 * q + 2]; o.w = w[4 * q + 3]; dst[q] = o; }
    }
    __syncthreads();
}
__device__ __forceinline__ void p0_prologue(Frame& F) {
    LAS float* scr = (LAS float*)(F.lds + F.wave * 16384);
    const float* c = F.in[1]; const float* c_ctx = F.in[3]; const float* ada_w = F.in[4]; const float* ada_b = F.in[5];
    float* LBo = (float*)(F.ws + WS_LB); float* PER = (float*)(F.ws + WS_PER); float* PEC = (float*)(F.ws + WS_PEC);
    constexpr int I_MOD = 96 * 8, I_LB = 16 + 16, I_PE = 24 * 8, I_WIN = 16 * 192, I_WP = 8 * 32, I_WO = 16 * 32;
    constexpr int NITEMS = I_MOD + I_LB + I_PE + I_WIN + 2 * I_WP + I_WO;
    const int lane = F.lane;
    for (int r0_ = 0; r0_ < 1 + MK_REP0B; ++r0_)
    for (int it = F.gw; it < NITEMS; it += F.NGW) {
        int r = it;
        if (r < I_MOD) {
            const int cchunk = r % 96, kp = r / 96, n = cchunk * 64 + lane; float a0 = 0.f, a1 = 0.f, a2 = 0.f;
            for (int kh = 0; kh < 2; ++kh) { const int k0 = kp * 128 + kh * 64;
                const float s0 = silu(c[k0 + lane]), s1 = silu(c[D + k0 + lane]), s2 = silu(c_ctx[k0 + lane]);
#pragma unroll 32
                for (int kk = 0; kk < 64; ++kk) { const float w = ada_w[(size_t)(k0 + kk) * INW + n];
                    a0 += __shfl(s0, kk) * w; a1 += __shfl(s1, kk) * w; a2 += __shfl(s2, kk) * w; }
            }
            const float bb = kp == 0 ? ada_b[n] : 0.f; float* mp = (float*)(F.ws + WS_MODP) + (size_t)kp * 3 * INW;
            mp[n] = a0 + bb; mp[INW + n] = a1 + bb; mp[2 * INW + n] = a2 + bb; continue;
        } r -= I_MOD;
        if (r < I_LB) {
            if (r < 16) { const int i = r * 64 + lane; const float* hl = F.in[9]; LBo[i] = 1.0f / (1.0f + __expf(hl[1024 + i] - hl[i])); }
            else { const int cc = (r - 16) * 64 + lane; float* WRT = (float*)(F.ws + WS_WRT);
                const f32x4 g4 = *(const GAS f32x4*)(F.in[24] + (size_t)cc * 4);
                WRT[cc] = g4.x; WRT[1024 + cc] = g4.y; WRT[2048 + cc] = g4.z; WRT[3072 + cc] = g4.w;
#pragma unroll
                for (int gq = 0; gq < 4; ++gq) { const f32x4 e0 = *(const GAS f32x4*)(F.in[26] + ((size_t)gq * D + cc) * 8), e1 = *(const GAS f32x4*)(F.in[26] + ((size_t)gq * D + cc) * 8 + 4);
                    float* wr = WRT + (size_t)(4 + gq * 8) * 1024 + cc;
                    wr[0] = e0.x; wr[1024] = e0.y; wr[2048] = e0.z; wr[3072] = e0.w; wr[4096] = e1.x; wr[5120] = e1.y; wr[6144] = e1.z; wr[7168] = e1.w; } }
            continue; } r -= I_LB;
        if (r < I_PE) {
            const int pos = r < 128 ? r : r - 128; float* dst = r < 128 ? PER + (size_t)r * 512 : PEC + (size_t)(r - 128) * 512;
#pragma unroll
            for (int e = 0; e < 8; ++e) { const int col = e * 64 + lane, jj = col & 255;
                const float omega = expf(-(float)jj / 256.0f * 9.210340371976184f), a = (float)pos * omega;
                dst[col] = (col >> 8) ? cosf(a) : sinf(a); }
            continue;
        } r -= I_PE;
        if (r < I_WIN) { p0_transpose_item(F.in[8], INW, (bf16_t*)(F.ws + WS_WIN_T), D, 0, scr, r, lane); continue; } r -= I_WIN;
        if (r < I_WP) { p0_transpose_item(F.in[21], D, (bf16_t*)(F.ws + WS_WA_T), 512, 0, scr, r, lane); continue; } r -= I_WP;
        if (r < I_WP) { p0_transpose_item(F.in[22], D, (bf16_t*)(F.ws + WS_WB_T), 512, 0, scr, r, lane); continue; } r -= I_WP;
        p0_transpose_item(F.in[23], D, (bf16_t*)(F.ws + WS_WO_T), D, 0, scr, r, lane);
    }
}
template <bool WRITE_XPOS>
__device__ __forceinline__ void p1_prep(Frame& F) {
    const float* x = F.in[0]; const float* ctx = F.in[2]; const float* g1 = F.in[6];
    const float* MODP = (const float*)(F.ws + WS_MODP); float* MOD = (float*)(F.ws + WS_MOD);
    const float* PER = (const float*)(F.ws + WS_PER); const float* PEC = (const float*)(F.ws + WS_PEC);
    bf16_t* HX = (bf16_t*)(F.ws + WS_HX);
    LAS float* m1s = (LAS float*)F.lds;
    const int lane = F.lane;
    for (int q = 0; q < 12; ++q) { const int idx = F.tid + NTHR * q, r = idx >> 11, col = idx & 2047; float a = 0.f;
#pragma unroll
        for (int kp = 0; kp < 8; ++kp) a += MODP[(size_t)(kp * 3 + r) * INW + col];
        m1s[idx] = a; }
    if (F.tid < 72) { const int idx = F.vcu * 72 + F.tid; if (idx < 3 * INW) { float a = 0.f;
#pragma unroll
        for (int kp = 0; kp < 8; ++kp) a += MODP[(size_t)kp * 3 * INW + idx];
        MOD[idx] = a; } }
    __syncthreads();
    f32x4 gv[4];
#pragma unroll
    for (int j = 0; j < 4; ++j) gv[j] = *(const GAS f32x4*)(g1 + 4 * lane + 256 * j);
    for (int row0 = F.gw; row0 < MR; row0 += 2 * F.NGW) {
        f32x4 v[2][4]; float ss[2]; bool ok[2];
#pragma unroll
        for (int r = 0; r < 2; ++r) { const int row = row0 + r * F.NGW; ok[r] = row < MR; const bool isx = row < T;
            const float* src = isx ? x + (size_t)row * D : ctx + (size_t)(row - T) * D;
#pragma unroll
            for (int j = 0; j < 4; ++j) v[r][j] = ok[r] ? *(const GAS f32x4*)(src + 4 * lane + 256 * j) : (f32x4){0.f, 0.f, 0.f, 0.f}; }
#pragma unroll
        for (int r = 0; r < 2; ++r) { const int row = row0 + r * F.NGW; const bool isx = row < T; const int t = row & (L - 1); ss[r] = 0.f;
#pragma unroll
            for (int j = 0; j < 4; ++j) { const int col = 4 * lane + 256 * j;
                if (isx) { const f32x4 pe = (j < 2) ? *(const GAS f32x4*)(PER + (size_t)(t >> 6) * 512 + col) : *(const GAS f32x4*)(PEC + (size_t)(t & 63) * 512 + col - 512); v[r][j] = v[r][j] + pe;
                           if (WRITE_XPOS) *(GAS f32x4*)(F.out + (size_t)row * D + col) = v[r][j]; }
                ss[r] += (v[r][j].x * v[r][j].x + v[r][j].y * v[r][j].y) + (v[r][j].z * v[r][j].z + v[r][j].w * v[r][j].w); } }
#pragma unroll
        for (int r = 0; r < 2; ++r) { const int row = row0 + r * F.NGW; if (ok[r]) {
            const int mr = row < T ? (row >> 13) : 2;
            const float rs = rsqrtf(wave_sum(ss[r]) * (1.0f / D) + EPS);
            GAS unsigned long long* o8 = (GAS unsigned long long*)(HX + (size_t)row * D) + lane;
#pragma unroll
            for (int j = 0; j < 4; ++j) { const int col = 4 * lane + 256 * j;
                const f32x4 sh = *(const LAS f32x4*)(m1s + mr * 2048 + col), sc = *(const LAS f32x4*)(m1s + mr * 2048 + 1024 + col);
                const f32x4 h = v[r][j] * rs * gv[j] * (sc + 1.0f) + sh;
                o8[64 * j] = (unsigned long long)pk2(h.x, h.y) | ((unsigned long long)pk2(h.z, h.w) << 32); } } }
    }
    __syncthreads();
}

constexpr size_t WS_YA = 216 * MiB, WS_YB = 232 * MiB;
constexpr size_t WS_SLU = 216 * MiB;
constexpr size_t WS_SLD = 232 * MiB;
constexpr int G_QS = 0, G_KT = 17408, G_KTT = 34816, G_VT = 53248, G_ST = 71680, G_PL = 106496, G_SEGT = 115712, G_DEC = 117760, G_TOT = 118272;
typedef short s16x8 __attribute__((ext_vector_type(8)));

__device__ __forceinline__ size_t gla_row(bool isctx, int dir, int b, int tau0, int tau) {
    if (isctx) { const int tc = dir ? (CTX - 1 - tau) : tau; return (size_t)(T + b * CTX + tc); }
    const int tx = tau0 + tau; const int t = dir ? (L - 1 - tx) : tx; return (size_t)(b * L + t);
}
template <int MODE>
__device__ __forceinline__ void gla_run(Frame& F, f32x4 (&S)[8], int b, int h, int dir, bool isctx, int tau0, int nch, bf16_t* Odir) {
    const bf16_t* P = (const bf16_t*)(F.ws + WS_P);
    const float* LBv = (const float*)(F.ws + WS_LB);
    LAS unsigned char* lds = F.lds;
    LAS bf16_t* QS = (LAS bf16_t*)(lds + G_QS); LAS bf16_t* KT = (LAS bf16_t*)(lds + G_KT); LAS bf16_t* KTT = (LAS bf16_t*)(lds + G_KTT); LAS bf16_t* VT = (LAS bf16_t*)(lds + G_VT);
    LAS bf16_t* ST = (LAS bf16_t*)(lds + G_ST); LAS bf16_t* PL = (LAS bf16_t*)(lds + G_PL);
    LAS float* SEGT = (LAS float*)(lds + G_SEGT); LAS float* DEC = (LAS float*)(lds + G_DEC); LAS float* TOT = (LAS float*)(lds + G_TOT);
    const int tid = F.tid, lane = F.lane, w = F.wave, kk = tid & 127, seg = tid >> 7, fr = lane & 15, fq = lane >> 4;
    const float lbv = LBv[dir * 512 + h * 128 + kk], oml = 1.0f - lbv;
    const int zc = (dir == 0 ? C_ZF : C_ZB) + h * 128 + kk, qc = C_Q + h * 128 + kk, vc = C_V + h * 128 + kk;
    if (MODE == 1) {
#pragma unroll
        for (int vt = 0; vt < 8; ++vt) { const unsigned lo = pk2(S[vt][0], S[vt][1]), hi = pk2(S[vt][2], S[vt][3]);
            *(LAS unsigned long long*)(ST + (16 * vt + fr) * 136 + 16 * w + 4 * fq) = (unsigned long long)lo | ((unsigned long long)hi << 32); }
    }
    if (tid < 128) TOT[tid] = 1.f;
    unsigned zr[16], qr[16], vr[16];
#define rowof(c_, j_) gla_row(isctx, dir, b, tau0, (c_) * 64 + (j_))
#define GLA_LOAD(c) do { _Pragma("unroll") for (int i = 0; i < 16; ++i) { const bf16_t* pr = P + rowof((c), seg * 16 + i) * INW; zr[i] = pr[zc]; vr[i] = pr[vc]; if (MODE == 1) qr[i] = pr[qc]; } } while (0)
    GLA_LOAD(0);
    for (int c = 0; c < nch; ++c) {
        float pf[16], kv[16];
#pragma unroll
        for (int i = 0; i < 16; ++i) { const float z = __uint_as_float(zr[i] << 16); const float e = __builtin_amdgcn_exp2f(z * -1.4426950408889634f), sg = __builtin_amdgcn_rcpf(1.0f + e);
            pf[i] = lbv + oml * sg; kv[i] = oml * e * sg; }
#pragma unroll
        for (int i = 1; i < 16; ++i) pf[i] *= pf[i - 1];
        SEGT[seg * 128 + kk] = pf[15];
        __syncthreads();
        float off = 1.f, tot = 1.f;
#pragma unroll
        for (int s2 = 0; s2 < 4; ++s2) { const float sv = SEGT[s2 * 128 + kk]; tot *= sv; off *= (s2 < seg) ? sv : 1.f; }
        unsigned ktp[8], vtp[8];
#pragma unroll
        for (int i = 0; i < 16; i += 2) {
            const float E0 = off * pf[i], E1 = off * pf[i + 1];
            const float k0 = kv[i] * __builtin_amdgcn_rcpf(E0), k1 = kv[i + 1] * __builtin_amdgcn_rcpf(E1);
            const unsigned kp = pk2(k0, k1);
            ktp[i >> 1] = kp; vtp[i >> 1] = vr[i] | (vr[i + 1] << 16);
            if (MODE == 1) {
                const float q0 = __uint_as_float(qr[i] << 16) * E0, q1 = __uint_as_float(qr[i + 1] << 16) * E1;
                const unsigned qp = pk2(q0, q1);
                const int j = seg * 16 + i;
                QS[j * 136 + kk] = (bf16_t)(qp & 0xffffu); QS[(j + 1) * 136 + kk] = (bf16_t)(qp >> 16);
                KT[j * 136 + kk] = (bf16_t)(kp & 0xffffu); KT[(j + 1) * 136 + kk] = (bf16_t)(kp >> 16);
            }
        }
        { LAS v4u* d1 = (LAS v4u*)(KTT + kk * 72 + seg * 16); v4u o; o.x = ktp[0]; o.y = ktp[1]; o.z = ktp[2]; o.w = ktp[3]; d1[0] = o; o.x = ktp[4]; o.y = ktp[5]; o.z = ktp[6]; o.w = ktp[7]; d1[1] = o;
          LAS v4u* d2 = (LAS v4u*)(VT + kk * 72 + seg * 16); o.x = vtp[0]; o.y = vtp[1]; o.z = vtp[2]; o.w = vtp[3]; d2[0] = o; o.x = vtp[4]; o.y = vtp[5]; o.z = vtp[6]; o.w = vtp[7]; d2[1] = o; }
        if (seg == 0) { DEC[kk] = tot; TOT[kk] *= tot; }
        if (c + 1 < nch) GLA_LOAD(c + 1);
        __syncthreads();
        if (MODE == 1) {
            const int tr = w >> 1;
            f32x4 sc[2] = {(f32x4){0.f, 0.f, 0.f, 0.f}, (f32x4){0.f, 0.f, 0.f, 0.f}};
#pragma unroll
            for (int ks = 0; ks < 4; ++ks) {
                const s16x8 a = *(const LAS s16x8*)(QS + (16 * tr + fr) * 136 + 32 * ks + 8 * fq);
#pragma unroll
                for (int q = 0; q < 2; ++q) { const int tcx = (w & 1) * 2 + q;
                    const s16x8 bb = *(const LAS s16x8*)(KT + (16 * tcx + fr) * 136 + 32 * ks + 8 * fq);
                    sc[q] = __builtin_amdgcn_mfma_f32_16x16x32_bf16(a, bb, sc[q], 0, 0, 0); }
            }
#pragma unroll
            for (int q = 0; q < 2; ++q) { const int tcx = (w & 1) * 2 + q; const int sidx = 16 * tcx + fr;
#pragma unroll
                for (int r = 0; r < 4; ++r) { const int tt = 16 * tr + 4 * fq + r; const float val = (sidx <= tt) ? sc[q][r] : 0.f;
                    PL[tt * 72 + sidx] = (bf16_t)f2bf(val); } }
            __syncthreads();
            const int tb = w & 3;
            f32x4 oc[4];
#pragma unroll
            for (int q = 0; q < 4; ++q) oc[q] = (f32x4){0.f, 0.f, 0.f, 0.f};
#pragma unroll
            for (int ks = 0; ks < 4; ++ks) {
                const s16x8 a = *(const LAS s16x8*)(QS + (16 * tb + fr) * 136 + 32 * ks + 8 * fq);
#pragma unroll
                for (int q = 0; q < 4; ++q) { const int vt = (w >> 2) * 4 + q;
                    const s16x8 bb = *(const LAS s16x8*)(ST + (16 * vt + fr) * 136 + 32 * ks + 8 * fq);
                    oc[q] = __builtin_amdgcn_mfma_f32_16x16x32_bf16(a, bb, oc[q], 0, 0, 0); }
            }
#pragma unroll
            for (int ks = 0; ks < 2; ++ks) {
                const s16x8 a = *(const LAS s16x8*)(PL + (16 * tb + fr) * 72 + 32 * ks + 8 * fq);
#pragma unroll
                for (int q = 0; q < 4; ++q) { const int vt = (w >> 2) * 4 + q;
                    const s16x8 bb = *(const LAS s16x8*)(VT + (16 * vt + fr) * 72 + 32 * ks + 8 * fq);
                    oc[q] = __builtin_amdgcn_mfma_f32_16x16x32_bf16(a, bb, oc[q], 0, 0, 0); }
            }
#pragma unroll
            for (int r = 0; r < 4; ++r) { const size_t row = rowof(c, 16 * tb + 4 * fq + r);
#pragma unroll
                for (int q = 0; q < 4; ++q) { const int vt = (w >> 2) * 4 + q; Odir[row * 512 + h * 128 + 16 * vt + fr] = (bf16_t)f2bf(oc[q][r]); } }
        }
        {
            s16x8 a[2];
#pragma unroll
            for (int ks = 0; ks < 2; ++ks) a[ks] = *(const LAS s16x8*)(KTT + (16 * w + fr) * 72 + 32 * ks + 8 * fq);
#pragma unroll
            for (int vt = 0; vt < 8; ++vt)
#pragma unroll
                for (int ks = 0; ks < 2; ++ks) { const s16x8 bb = *(const LAS s16x8*)(VT + (16 * vt + fr) * 72 + 32 * ks + 8 * fq);
                    S[vt] = __builtin_amdgcn_mfma_f32_16x16x32_bf16(a[ks], bb, S[vt], 0, 0, 0); }
            const f32x4 dv = *(const LAS f32x4*)(DEC + 16 * w + 4 * fq);
#pragma unroll
            for (int vt = 0; vt < 8; ++vt) S[vt] = S[vt] * dv;
        }
        __syncthreads();
        if (MODE == 1 && c + 1 < nch) {
#pragma unroll
            for (int vt = 0; vt < 8; ++vt) { const unsigned lo = pk2(S[vt][0], S[vt][1]), hi = pk2(S[vt][2], S[vt][3]);
                *(LAS unsigned long long*)(ST + (16 * vt + fr) * 136 + 16 * w + 4 * fq) = (unsigned long long)lo | ((unsigned long long)hi << 32); }
        }
    }
#undef GLA_LOAD
#undef rowof
    __syncthreads();
}
__device__ __forceinline__ void gla_item_state(Frame& F, int b, int h, int dir, int tau0, int nch, int oslot) {
    float* SLU = (float*)(F.ws + WS_SLU); float* SLD = (float*)(F.ws + WS_SLD);
    LAS float* TOT = (LAS float*)(F.lds + G_TOT);
    f32x4 S[8];
#pragma unroll
    for (int vt = 0; vt < 8; ++vt) S[vt] = (f32x4){0.f, 0.f, 0.f, 0.f};
    gla_run<0>(F, S, b, h, dir, false, tau0, nch, nullptr);
    f32x4* uo = (f32x4*)(SLU + (size_t)oslot * 16384) + (F.wave * 8) * 64 + F.lane;
#pragma unroll
    for (int vt = 0; vt < 8; ++vt) uo[vt * 64] = S[vt];
    if (F.tid < 128) SLD[(size_t)oslot * 128 + F.tid] = TOT[F.tid];
    __syncthreads();
}
__device__ __forceinline__ void gla_item_full(Frame& F, int b, int h, int dir, int scn, int cbase, bf16_t* Odir) {
    const float* SLU = (const float*)(F.ws + WS_SLU); const float* SLD = (const float*)(F.ws + WS_SLD);
    const int w = F.wave, lane = F.lane, fq = lane >> 4;
    f32x4 S[8];
#pragma unroll
    for (int vt = 0; vt < 8; ++vt) S[vt] = (f32x4){0.f, 0.f, 0.f, 0.f};
    gla_run<0>(F, S, b, h, dir, true, 0, CTX / 64, nullptr);
    for (int j = 1; j <= scn; ++j) {
        const f32x4* uj = (const f32x4*)(SLU + (size_t)(cbase + j) * 16384) + (w * 8) * 64 + lane;
        const f32x4 dj = *(const f32x4*)(SLD + (size_t)(cbase + j) * 128 + 16 * w + 4 * fq);
#pragma unroll
        for (int vt = 0; vt < 8; ++vt) S[vt] = dj * S[vt] + uj[vt * 64];
    }
    gla_run<1>(F, S, b, h, dir, false, scn * 512, 8, Odir);
}
__device__ __forceinline__ void gla_pass_a(Frame& F) {
    for (int it = F.vcu - 16; it >= 0 && it < 240; it += F.G) {
        const int ch = it / 15, j = it % 15, b = ch >> 3, h = (ch >> 1) & 3, dir = ch & 1;
        gla_item_state(F, b, h, dir, j * 512, 8, ch * 16 + j + 1);
    }
}
__device__ __forceinline__ void gla_pass_b(Frame& F, bf16_t* Of, bf16_t* Ob) {
    for (int it = F.vcu; it < 256; it += F.G) {
        const int ch = it >> 4, scn = it & 15, b = ch >> 3, h = (ch >> 1) & 3, dir = ch & 1;
        gla_item_full(F, b, h, dir, scn, ch * 16, dir ? Ob : Of);
    }
}

typedef float f32x16 __attribute__((ext_vector_type(16)));
__device__ __forceinline__ void hy_pre(Frame& F) {
    const bf16_t* P = (const bf16_t*)(F.ws + WS_P); bf16_t* UT = (bf16_t*)(F.ws + WS_UT);
    const float* cw = F.in[11]; const float* cb = F.in[12];
    LAS bf16_t* scr = (LAS bf16_t*)(F.lds + F.wave * 16384);
    const int lane = F.lane;
    for (int it = F.gw; it < 2 * 128 * 8; it += F.NGW) {
        const int ct = it & 7, tt = (it >> 3) & 127, b = it >> 10, c = ct * 64 + lane, t0 = tt * 64;
        const float wv0 = cw[c], wv1 = cw[1536 + c], wv2 = cw[3072 + c], bv = cb[c];
        const float wx0 = cw[512 + c], wx1 = cw[1536 + 512 + c], wx2 = cw[3072 + 512 + c], bx = cb[512 + c];
        const bf16_t* pb = P + (size_t)b * L * INW + C_HY + c;
        float vm = 0.f, xm = 0.f, v0, x0;
        if (t0 > 0) { vm = bf2f_(pb[(size_t)(t0 - 1) * INW]); xm = bf2f_(pb[(size_t)(t0 - 1) * INW + 512]); }
        v0 = bf2f_(pb[(size_t)t0 * INW]); x0 = bf2f_(pb[(size_t)t0 * INW + 512]);
#pragma unroll 8
        for (int j = 0; j < 64; j += 2) {
            float vp = 0.f, xp = 0.f, vp2 = 0.f, xp2 = 0.f;
            if (t0 + j + 1 < L) { vp = bf2f_(pb[(size_t)(t0 + j + 1) * INW]); xp = bf2f_(pb[(size_t)(t0 + j + 1) * INW + 512]); }
            if (t0 + j + 2 < L) { vp2 = bf2f_(pb[(size_t)(t0 + j + 2) * INW]); xp2 = bf2f_(pb[(size_t)(t0 + j + 2) * INW + 512]); }
            const float u0 = (bv + wv0 * vm + wv1 * v0 + wv2 * vp) * (bx + wx0 * xm + wx1 * x0 + wx2 * xp);
            const float u1 = (bv + wv0 * v0 + wv1 * vp + wv2 * vp2) * (bx + wx0 * x0 + wx1 * xp + wx2 * xp2);
            *(LAS unsigned*)(scr + lane * 72 + j) = pk2(u0, u1);
            vm = vp; xm = xp; v0 = vp2; x0 = xp2;
        }
        LDS_WAIT(); asm volatile("" ::: "memory");
#pragma unroll
        for (int q = 0; q < 8; ++q) { const int row = (lane >> 3) + 8 * q, pc = lane & 7;
            const v4u val = *(const LAS v4u*)(scr + row * 72 + pc * 8);
            *(GAS v4u*)(UT + ((size_t)(b * 512 + ct * 64 + row)) * L + t0 + pc * 8) = val; }
        LDS_WAIT(); asm volatile("" ::: "memory");
    }
}
constexpr int HY_UOFF = 0, HY_ZOFF = 73728, HY_FOFF = 73984, HY_FWIN = 135 * 128, HY_NG = 16;
__device__ __forceinline__ void hy_conv(Frame& F) {
    const bf16_t* UT = (const bf16_t*)(F.ws + WS_UT); const bf16_t* GR = (const bf16_t*)(F.ws + WS_GR); bf16_t* YT = (bf16_t*)(F.ws + WS_YT);
    LAS unsigned char* lds = F.lds;
    const int tid = F.tid, lane = F.lane, w = F.wave, ci = w >> 2, cwv = w & 3, b = cwv >> 1, r = lane & 31, hh = lane >> 5;
    const int s0a = (cwv & 1) ? 32 : 0, s0b = (cwv & 1) ? 64 : 96;
    for (int it = F.vcu; it < 256; it += F.G) {
        const int c0 = 2 * it;
#pragma unroll
        for (int q = 0; q < 8; ++q) { const int ch = tid + q * NTHR, row = ch >> 10, cr = ch & 1023, cc = row >> 1, bb = row & 1;
            const v4u val = *(const GAS v4u*)(UT + ((size_t)(bb * 512 + c0 + cc)) * L + cr * 8);
            *(LAS v4u*)(lds + HY_UOFF + (row * 128 + (cr >> 3)) * 144 + (cr & 7) * 16) = val; }
        if (tid < 9) *(LAS v4u*)(lds + HY_ZOFF + tid * 16) = (v4u){0u, 0u, 0u, 0u};
        const int wc = tid / 135, wq = tid % 135;
        const int wc2 = wc < 2 ? wc : 1, wq2 = wc < 2 ? wq : 0;
        v4u wl0, wl1; bool wvalid;
#define HY_WLOAD(g_) do { const int qb_ = 1016 - 8 * (-112 + 16 * (g_)); const int q_ = qb_ + wq2; wvalid = (q_ >= 0 && q_ < 2047); const int qc_ = q_ < 0 ? 0 : (q_ > 2046 ? 2046 : q_); \
            const GAS v4u* src_ = (const GAS v4u*)(GR + (size_t)(c0 + wc2) * 16384 + 8 * qc_); wl0 = src_[0]; wl1 = src_[1]; } while (0)
#define HY_WSTORE(buf_) do { if (tid < 270) { const unsigned zm_ = wvalid ? 0xffffffffu : 0u; \
            const unsigned ww_[8] = {wl0.x & zm_, wl0.y & zm_, wl0.z & zm_, wl0.w & zm_, wl1.x & zm_, wl1.y & zm_, wl1.z & zm_, wl1.w & zm_}; \
            LAS v4u* dst_ = (LAS v4u*)(lds + HY_FOFF + ((buf_) * 2 + wc) * HY_FWIN + wq * 128); \
            _Pragma("unroll") for (int m_ = 0; m_ < 4; ++m_) { \
                v4u e_; e_.x = ww_[m_]; e_.y = ww_[m_ + 1]; e_.z = ww_[m_ + 2]; e_.w = ww_[m_ + 3]; dst_[2 * m_] = e_; \
                v4u o_; o_.x = __builtin_amdgcn_alignbit(ww_[m_ + 1], ww_[m_], 16); o_.y = __builtin_amdgcn_alignbit(ww_[m_ + 2], ww_[m_ + 1], 16); \
                o_.z = __builtin_amdgcn_alignbit(ww_[m_ + 3], ww_[m_ + 2], 16); o_.w = __builtin_amdgcn_alignbit(ww_[m_ + 4], ww_[m_ + 3], 16); dst_[2 * m_ + 1] = o_; } } } while (0)
        HY_WLOAD(0); HY_WSTORE(0);
        __syncthreads();
        f32x16 acc[2][2];
#pragma unroll
        for (int m = 0; m < 2; ++m)
#pragma unroll
            for (int s = 0; s < 2; ++s)
#pragma unroll
                for (int e = 0; e < 16; ++e) acc[m][s][e] = 0.f;
        const int aidx = 7 - (r & 7), qa = 1023 - (r >> 3) + hh;
        for (int g = 0; g < HY_NG; ++g) {
            if (g + 1 < HY_NG) HY_WLOAD(g + 1);
            const int dmin = -127 + 16 * g, qbase = 1016 - 8 * (dmin + 15);
            const LAS unsigned char* fw = lds + HY_FOFF + ((g & 1) * 2 + ci) * HY_FWIN + aidx * 16;
            for (int dd = 0; dd < 16; ++dd) {
                const int d = dmin + dd;
                const bool act0 = (d >= s0a - 127) && (d <= s0a + 31), act1 = (d >= s0b - 127) && (d <= s0b + 31);
                if (d > 127 || !(act0 || act1)) continue;
                s16x8 A[2][4];
                const LAS unsigned char* fa = fw + (qa - 8 * d - qbase) * 128;
#pragma unroll
                for (int mt = 0; mt < 2; ++mt)
#pragma unroll
                    for (int ks = 0; ks < 4; ++ks) A[mt][ks] = *(const LAS s16x8*)(fa + (2 * ks - 4 * mt) * 128);
#pragma unroll
                for (int s = 0; s < 2; ++s) {
                    if (s == 0 ? act0 : act1) {
                        const int ip = (s == 0 ? s0a : s0b) + r - d;
                        const LAS unsigned char* ub = (ip >= 0 && ip < 128) ? lds + HY_UOFF + ((ci * 2 + b) * 128 + ip) * 144 + hh * 16 : lds + HY_ZOFF + hh * 16;
                        s16x8 Bf[4];
#pragma unroll
                        for (int ks = 0; ks < 4; ++ks) Bf[ks] = *(const LAS s16x8*)(ub + ks * 32);
                        __builtin_amdgcn_s_setprio(1);
#pragma unroll
                        for (int mt = 0; mt < 2; ++mt)
#pragma unroll
                            for (int ks = 0; ks < 4; ++ks) acc[mt][s] = __builtin_amdgcn_mfma_f32_32x32x16_bf16(A[mt][ks], Bf[ks], acc[mt][s], 0, 0, 0);
                        __builtin_amdgcn_s_setprio(0);
                    }
                }
            }
            if (g + 1 < HY_NG) HY_WSTORE((g + 1) & 1);
            __syncthreads();
        }
#undef HY_WLOAD
#undef HY_WSTORE
        bf16_t* yb = YT + ((size_t)(b * 512 + c0 + ci)) * L;
#pragma unroll
        for (int s = 0; s < 2; ++s) { const int i = (s == 0 ? s0a : s0b) + r;
#pragma unroll
            for (int mt = 0; mt < 2; ++mt)
#pragma unroll
                for (int g4 = 0; g4 < 4; ++g4) { const f32x16& a = acc[mt][s];
                    const unsigned lo = pk2(a[4 * g4], a[4 * g4 + 1]), hi = pk2(a[4 * g4 + 2], a[4 * g4 + 3]);
                    *(GAS unsigned long long*)(yb + 64 * i + 32 * mt + 8 * g4 + 4 * hh) = (unsigned long long)lo | ((unsigned long long)hi << 32); } }
        __syncthreads();
    }
}
constexpr int H2_UOFF = 0, H2_ZOFF = 69632, H2_FOFF = 69920 + 96  , H2_NQ = 143, H2_FWIN = H2_NQ * 128, H2_NG = 16, H2_DG = 8;
__device__ __forceinline__ void hy_conv128(Frame& F) {
    const bf16_t* UT = (const bf16_t*)(F.ws + WS_UT); const bf16_t* GR = (const bf16_t*)(F.ws + WS_GR); bf16_t* YT = (bf16_t*)(F.ws + WS_YT);
    LAS unsigned char* lds = F.lds;
    const int tid = F.tid, lane = F.lane, w = F.wave, ci = w >> 2, b = (w >> 1) & 1, s0 = (w & 1) * 32, r = lane & 15, g4 = lane >> 4;
    for (int it = F.vcu; it < 256; it += F.G) {
        const int c0 = 2 * it;
#pragma unroll
        for (int q = 0; q < 8; ++q) { const int ch = tid + q * NTHR, row = ch >> 10, cr = ch & 1023, cc = row >> 1, bb = row & 1;
            const v4u val = *(const GAS v4u*)(UT + ((size_t)(bb * 512 + c0 + cc)) * L + cr * 8);
            *(LAS v4u*)(lds + H2_UOFF + (row * 64 + (cr >> 4)) * 272 + (cr & 15) * 16) = val; }
        if (tid < 17) *(LAS v4u*)(lds + H2_ZOFF + tid * 16) = (v4u){0u, 0u, 0u, 0u};
        const int wc = tid / H2_NQ, wq = tid % H2_NQ;
        const int wc2 = wc < 2 ? wc : 1, wq2 = wc < 2 ? wq : 0;
        v4u wl0, wl1; bool wvalid;
#define H2_WLOAD(g_) do { const int qb_ = 1008 - 16 * (-56 + 8 * (g_)); const int q_ = qb_ + wq2; wvalid = (q_ >= 0 && q_ < 2047); const int qc_ = q_ < 0 ? 0 : (q_ > 2046 ? 2046 : q_); \
            const GAS v4u* src_ = (const GAS v4u*)(GR + (size_t)(c0 + wc2) * 16384 + 8 * qc_); wl0 = src_[0]; wl1 = src_[1]; } while (0)
#define H2_WSTORE(buf_) do { if (tid < 2 * H2_NQ) { const unsigned zm_ = wvalid ? 0xffffffffu : 0u; \
            const unsigned ww_[8] = {wl0.x & zm_, wl0.y & zm_, wl0.z & zm_, wl0.w & zm_, wl1.x & zm_, wl1.y & zm_, wl1.z & zm_, wl1.w & zm_}; \
            LAS v4u* dst_ = (LAS v4u*)(lds + H2_FOFF + ((buf_) * 2 + wc) * H2_FWIN + wq * 128); \
            _Pragma("unroll") for (int m_ = 0; m_ < 4; ++m_) { \
                v4u e_; e_.x = ww_[m_]; e_.y = ww_[m_ + 1]; e_.z = ww_[m_ + 2]; e_.w = ww_[m_ + 3]; dst_[2 * m_] = e_; \
                v4u o_; o_.x = __builtin_amdgcn_alignbit(ww_[m_ + 1], ww_[m_], 16); o_.y = __builtin_amdgcn_alignbit(ww_[m_ + 2], ww_[m_ + 1], 16); \
                o_.z = __builtin_amdgcn_alignbit(ww_[m_ + 3], ww_[m_ + 2], 16); o_.w = __builtin_amdgcn_alignbit(ww_[m_ + 4], ww_[m_ + 3], 16); dst_[2 * m_ + 1] = o_; } } } while (0)
        H2_WLOAD(0); H2_WSTORE(0);
        __syncthreads();
        f32x4 acc[8][2];
#pragma unroll
        for (int rt = 0; rt < 8; ++rt)
#pragma unroll
            for (int ct = 0; ct < 2; ++ct) acc[rt][ct] = (f32x4){0.f, 0.f, 0.f, 0.f};
        const int aidx = 7 - (r & 7), qa = 1023 - (r >> 3) + g4;
        for (int g = 0; g < H2_NG; ++g) {
            if (g + 1 < H2_NG) H2_WLOAD(g + 1);
            const int dmin = -63 + H2_DG * g, qbase = 1008 - 16 * (dmin + H2_DG - 1);
            const LAS unsigned char* fw = lds + H2_FOFF + ((g & 1) * 2 + ci) * H2_FWIN + aidx * 16;
            for (int dd = 0; dd < H2_DG; ++dd) {
                const int d = dmin + dd;
                const bool act0 = (d >= s0 - 63) && (d <= s0 + 15), act1 = (d >= s0 + 16 - 63) && (d <= s0 + 31);
                if (d > 63 || !(act0 || act1)) continue;
                s16x8 A[14];
                const LAS unsigned char* fa = fw + (qa - 16 * d - qbase) * 128;
#pragma unroll
                for (int f = 0; f < 14; ++f) A[f] = *(const LAS s16x8*)(fa + 2 * (f - 7) * 128);
#pragma unroll
                for (int ct = 0; ct < 2; ++ct) {
                    if (ct == 0 ? act0 : act1) {
                        const int ip = s0 + 16 * ct + r - d;
                        const LAS unsigned char* ub = (ip >= 0 && ip < 64) ? lds + H2_UOFF + ((ci * 2 + b) * 64 + ip) * 272 + g4 * 16 : lds + H2_ZOFF + g4 * 16;
                        s16x8 Bf[4];
#pragma unroll
                        for (int ks = 0; ks < 4; ++ks) Bf[ks] = *(const LAS s16x8*)(ub + ks * 64);
#pragma unroll
                        for (int rt = 0; rt < 8; ++rt)
#pragma unroll
                            for (int ks = 0; ks < 4; ++ks) acc[rt][ct] = __builtin_amdgcn_mfma_f32_16x16x32_bf16(A[2 * ks - rt + 7], Bf[ks], acc[rt][ct], 0, 0, 0);
                    }
                }
            }
            if (g + 1 < H2_NG) H2_WSTORE((g + 1) & 1);
            __syncthreads();
        }
#undef H2_WLOAD
#undef H2_WSTORE
        bf16_t* yb = YT + ((size_t)(b * 512 + c0 + ci)) * L;
#pragma unroll
        for (int ct = 0; ct < 2; ++ct) { const int i = s0 + 16 * ct + r;
#pragma unroll
            for (int rt = 0; rt < 8; ++rt) { const f32x4 a = acc[rt][ct];
                const unsigned lo = pk2(a[0], a[1]), hi = pk2(a[2], a[3]);
                *(GAS unsigned long long*)(yb + 128 * i + 16 * rt + 4 * g4) = (unsigned long long)lo | ((unsigned long long)hi << 32); } }
        __syncthreads();
    }
}
__device__ __forceinline__ void p6_post(Frame& F, const bf16_t* Of, const bf16_t* Ob, bf16_t* YA, bf16_t* YB) {
    const bf16_t* P = (const bf16_t*)(F.ws + WS_P); const bf16_t* YT = (const bf16_t*)(F.ws + WS_YT);
    const float* cw = F.in[11]; const float* cb = F.in[12]; const float* ng = F.in[10];
    const int lane = F.lane;
    const f32x4 n0 = *(const GAS f32x4*)(ng + ((8 * lane) & 127)), n1 = *(const GAS f32x4*)(ng + ((8 * lane) & 127) + 4);
    for (int t0 = F.gw; t0 < T; t0 += 4 * F.NGW) {
        v4u af[4], ab[4], gr[4];
#pragma unroll
        for (int r = 0; r < 4; ++r) { const int t = (t0 + r * F.NGW < T) ? t0 + r * F.NGW : t0;
            af[r] = *(const GAS v4u*)(Of + (size_t)t * 512 + 8 * lane); ab[r] = *(const GAS v4u*)(Ob + (size_t)t * 512 + 8 * lane); gr[r] = *(const GAS v4u*)(P + (size_t)t * INW + C_G + 8 * lane); }
#pragma unroll
        for (int r = 0; r < 4; ++r) { const int t = t0 + r * F.NGW;
            const unsigned fa[4] = {af[r].x, af[r].y, af[r].z, af[r].w}, fb[4] = {ab[r].x, ab[r].y, ab[r].z, ab[r].w}, fg[4] = {gr[r].x, gr[r].y, gr[r].z, gr[r].w};
            float o[8], g[8]; float ss = 0.f;
#pragma unroll
            for (int q = 0; q < 4; ++q) { o[2 * q] = __uint_as_float(fa[q] << 16) + __uint_as_float(fb[q] << 16); o[2 * q + 1] = __uint_as_float(fa[q] & 0xffff0000u) + __uint_as_float(fb[q] & 0xffff0000u);
                g[2 * q] = __uint_as_float(fg[q] << 16); g[2 * q + 1] = __uint_as_float(fg[q] & 0xffff0000u); ss += o[2 * q] * o[2 * q] + o[2 * q + 1] * o[2 * q + 1]; }
            ss = row16_sum(ss);
            const float rs = rsqrtf(ss * (1.0f / 128.0f) + EPS);
            const float nn[8] = {n0.x, n0.y, n0.z, n0.w, n1.x, n1.y, n1.z, n1.w};
            float y[8];
#pragma unroll
            for (int q = 0; q < 8; ++q) y[q] = o[q] * rs * nn[q] * silu(g[q]);
            v4u ov; ov.x = pk2(y[0], y[1]); ov.y = pk2(y[2], y[3]); ov.z = pk2(y[4], y[5]); ov.w = pk2(y[6], y[7]);
            if (t < T) *(GAS v4u*)(YA + (size_t)t * 512 + 8 * lane) = ov; }
    }
    LAS bf16_t* scr = (LAS bf16_t*)(F.lds + F.wave * 16384);
    for (int it = F.gw; it < 2 * 128 * 8; it += F.NGW) {
        const int ct = it & 7, tt = (it >> 3) & 127, b = it >> 10, c = ct * 64 + lane, t0 = tt * 64;
#pragma unroll
        for (int q = 0; q < 8; ++q) { const int row = (lane >> 3) + 8 * q, pc = lane & 7;
            *(LAS v4u*)(scr + row * 72 + pc * 8) = *(const GAS v4u*)(YT + ((size_t)(b * 512 + ct * 64 + row)) * L + t0 + pc * 8); }
        LDS_WAIT(); asm volatile("" ::: "memory");
        const float w0 = cw[1024 + c], w1 = cw[1536 + 1024 + c], w2 = cw[3072 + 1024 + c], bb = cb[1024 + c];
        const bf16_t* pb = P + (size_t)b * L * INW + C_HY + 1024 + c;
        float xm = 0.f, x0;
        if (t0 > 0) xm = bf2f_(pb[(size_t)(t0 - 1) * INW]);
        x0 = bf2f_(pb[(size_t)t0 * INW]);
        bf16_t* yo = YB + ((size_t)b * L + t0) * 512 + c;
#pragma unroll 8
        for (int j = 0; j < 64; j += 2) {
            float xp = 0.f, xp2 = 0.f;
            if (t0 + j + 1 < L) xp = bf2f_(pb[(size_t)(t0 + j + 1) * INW]);
            if (t0 + j + 2 < L) xp2 = bf2f_(pb[(size_t)(t0 + j + 2) * INW]);
            const unsigned yy = *(const LAS unsigned*)(scr + lane * 72 + j);
            const float r0 = (bb + w0 * xm + w1 * x0 + w2 * xp) * __uint_as_float(yy << 16);
            const float r1 = (bb + w0 * x0 + w1 * xp + w2 * xp2) * __uint_as_float(yy & 0xffff0000u);
            yo[(size_t)j * 512] = (bf16_t)f2bf(r0); yo[(size_t)(j + 1) * 512] = (bf16_t)f2bf(r1);
            xm = xp; x0 = xp2;
        }
        LDS_WAIT(); asm volatile("" ::: "memory");
    }
}

constexpr size_t WS_MIXED = 248 * MiB;
constexpr size_t WS_GU_T = 18 * MiB;
constexpr size_t WS_DN_T = 82 * MiB;
constexpr size_t WS_H2 = 114 * MiB;
constexpr size_t WS_HS = 146 * MiB;
constexpr size_t WS_HID = 226 * MiB;
constexpr size_t WS_Y = 114 * MiB;
constexpr size_t WS_TOKE = 266 * MiB;
constexpr size_t WS_TOKW = 266 * MiB + 128 * 1024;
constexpr size_t WS_TOKS = 266 * MiB + 256 * 1024;
constexpr size_t WS_SLOTW = 266 * MiB + 384 * 1024;
constexpr size_t WS_TILEE = 266 * MiB + 640 * 1024;
constexpr size_t WS_TOKR = 266 * MiB + 768 * 1024;
constexpr size_t WS_SLOTT = 267 * MiB;
constexpr size_t WS_CNTBLK = 266 * MiB + 896 * 1024;
constexpr int MAXTILES = 160;

__device__ __forceinline__ void transpose_tile(const float* W, int N, int k0, int n0, bf16_t* WT, int orow0, int ldk, int kout0, LAS float* scr, int lane) {
    float tv[32];
#pragma unroll
    for (int i = 0; i < 32; ++i) tv[i] = W[(size_t)(k0 + 2 * i + (lane >> 5)) * N + n0 + (lane & 31)];
#pragma unroll
    for (int i = 0; i < 32; ++i) scr[(2 * i + (lane >> 5)) * 33 + (lane & 31)] = tv[i];
    LDS_WAIT(); asm volatile("" ::: "memory");
    const int c = lane & 7;
#pragma unroll
    for (int j = 0; j < 4; ++j) { const int n = (lane >> 3) + 8 * j; const LAS float* s = scr + (8 * c) * 33 + n;
        v4u o; o.x = pk2(s[0 * 33], s[1 * 33]); o.y = pk2(s[2 * 33], s[3 * 33]); o.z = pk2(s[4 * 33], s[5 * 33]); o.w = pk2(s[6 * 33], s[7 * 33]);
        *(GAS v4u*)(WT + (size_t)(orow0 + n) * ldk + kout0 + 8 * c) = o; }
    LDS_WAIT(); asm volatile("" ::: "memory");
}
__device__ __forceinline__ void p9_router(Frame& F) {
    const float* X1 = F.out; const float* g2 = F.in[7]; const float* MOD = (const float*)(F.ws + WS_MOD);
    const float* WRT = (const float*)(F.ws + WS_WRT); const float* bg = F.in[25]; const float* be = F.in[27];
    bf16_t* H2 = (bf16_t*)(F.ws + WS_H2); int* toke = (int*)(F.ws + WS_TOKE); float* tokw = (float*)(F.ws + WS_TOKW);
    const int lane = F.lane;
    LAS unsigned* lcnt = (LAS unsigned*)(F.lds);
    int* tokr = (int*)(F.ws + WS_TOKR); unsigned* cntblk = (unsigned*)(F.ws + WS_CNTBLK);
    if (F.tid < 32) lcnt[F.tid] = 0u;
    { int* slott = (int*)(F.ws + WS_SLOTT); for (int i = F.vcu * NTHR + F.tid; i < MAXTILES * 256; i += F.G * NTHR) slott[i] = 0; }
    __syncthreads();
    const int TPB = T / F.G;
    constexpr int RT = 2;
    f32x4 g2v[4];
#pragma unroll
    for (int j = 0; j < 4; ++j) g2v[j] = *(const GAS f32x4*)(g2 + 4 * lane + 256 * j);
    for (int tt0 = F.wave; tt0 < TPB; tt0 += NWAVES * RT) {
        f32x4 v[RT][4]; float ss[RT]; int tk[RT];
#pragma unroll
        for (int r = 0; r < RT; ++r) { const int tt = tt0 + r * NWAVES; tk[r] = F.vcu * TPB + (tt < TPB ? tt : tt0);
#pragma unroll
            for (int j = 0; j < 4; ++j) v[r][j] = *(const GAS f32x4*)(X1 + (size_t)tk[r] * D + 4 * lane + 256 * j); }
#pragma unroll
        for (int r = 0; r < RT; ++r) { ss[r] = 0.f;
#pragma unroll
            for (int j = 0; j < 4; ++j) ss[r] += (v[r][j].x * v[r][j].x + v[r][j].y * v[r][j].y) + (v[r][j].z * v[r][j].z + v[r][j].w * v[r][j].w); }
#pragma unroll
        for (int r = 0; r < RT; ++r) ss[r] = rsqrtf(wave_sum(ss[r]) * (1.0f / D) + EPS);
        float pg[RT][4];
#pragma unroll
        for (int r = 0; r < RT; ++r) { const int b = tk[r] >> 13; pg[r][0] = 0.f; pg[r][1] = 0.f; pg[r][2] = 0.f; pg[r][3] = 0.f;
            GAS unsigned long long* o8 = (GAS unsigned long long*)(H2 + (size_t)tk[r] * D) + lane;
#pragma unroll
            for (int j = 0; j < 4; ++j) { const int col = 4 * lane + 256 * j;
                const f32x4 sc = *(const GAS f32x4*)(MOD + b * INW + 4096 + col), sh = *(const GAS f32x4*)(MOD + b * INW + 3072 + col);
                v[r][j] = v[r][j] * ss[r] * g2v[j] * (sc + 1.0f) + sh;
                if (tt0 + r * NWAVES < TPB) o8[64 * j] = (unsigned long long)pk2(v[r][j].x, v[r][j].y) | ((unsigned long long)pk2(v[r][j].z, v[r][j].w) << 32); } }
#pragma unroll
        for (int q = 0; q < 4; ++q)
#pragma unroll
            for (int j = 0; j < 4; ++j) { const f32x4 wr = *(const GAS f32x4*)(WRT + q * 1024 + 4 * lane + 256 * j);
#pragma unroll
                for (int r = 0; r < RT; ++r) pg[r][q] += (v[r][j].x * wr.x + v[r][j].y * wr.y) + (v[r][j].z * wr.z + v[r][j].w * wr.w); }
        int gi[RT]; float ptop[RT];
#pragma unroll
        for (int r = 0; r < RT; ++r) {
#pragma unroll
            for (int q = 0; q < 4; ++q) pg[r][q] = wave_sum(pg[r][q]) + bg[q];
            gi[r] = 0; float lmax = pg[r][0];
#pragma unroll
            for (int q = 1; q < 4; ++q) if (pg[r][q] > lmax) { lmax = pg[r][q]; gi[r] = q; }
            float den = 0.f;
#pragma unroll
            for (int q = 0; q < 4; ++q) den += expf(pg[r][q] - lmax);
            ptop[r] = 1.0f / den; }
        float pe[RT][8];
#pragma unroll
        for (int r = 0; r < RT; ++r) { const float* weg = WRT + (size_t)(4 + gi[r] * 8) * 1024 + 4 * lane;
#pragma unroll
            for (int q = 0; q < 8; ++q) { pe[r][q] = 0.f;
#pragma unroll
                for (int j = 0; j < 4; ++j) { const f32x4 wr = *(const GAS f32x4*)(weg + q * 1024 + 256 * j);
                    pe[r][q] += (v[r][j].x * wr.x + v[r][j].y * wr.y) + (v[r][j].z * wr.z + v[r][j].w * wr.w); } } }
#pragma unroll
        for (int r = 0; r < RT; ++r) {
#pragma unroll
            for (int q = 0; q < 8; ++q) pe[r][q] = wave_sum(pe[r][q]) + be[gi[r] * 8 + q];
            float l1 = pe[r][0]; int i1 = 0;
#pragma unroll
            for (int q = 1; q < 8; ++q) if (pe[r][q] > l1) { l1 = pe[r][q]; i1 = q; }
            float l2 = -3.0e38f; int i2 = 0;
#pragma unroll
            for (int q = 0; q < 8; ++q) if (q != i1 && pe[r][q] > l2) { l2 = pe[r][q]; i2 = q; }
            const float e2 = expf(l2 - l1);
            if (lane == 0 && tt0 + r * NWAVES < TPB) {
                const int t = tk[r], ea = gi[r] * 8 + i1, eb = gi[r] * 8 + i2;
                toke[t * 2] = ea; toke[t * 2 + 1] = eb;
                tokw[t * 2] = ptop[r] / (1.0f + e2); tokw[t * 2 + 1] = ptop[r] * e2 / (1.0f + e2);
                tokr[t * 2] = (int)__hip_atomic_fetch_add(lcnt + ea, 1u, __ATOMIC_RELAXED, __HIP_MEMORY_SCOPE_WORKGROUP);
                tokr[t * 2 + 1] = (int)__hip_atomic_fetch_add(lcnt + eb, 1u, __ATOMIC_RELAXED, __HIP_MEMORY_SCOPE_WORKGROUP);
            } }
    }
    __syncthreads();
    if (F.tid < 32) cntblk[F.vcu * 32 + F.tid] = lcnt[F.tid];
    __syncthreads();
}
__device__ __forceinline__ void p9_weights(Frame& F) {
    const int lane = F.lane;
    LAS float* scr = (LAS float*)(F.lds + F.wave * 16384);
    bf16_t* GU = (bf16_t*)(F.ws + WS_GU_T); bf16_t* DN = (bf16_t*)(F.ws + WS_DN_T);
    for (int it = F.gw; it < 32 * 768; it += F.NGW) {
        const int e = it / 768, r = it % 768;
        if (r < 512) {
            const int up = r >> 8, q = r & 255, kb = q >> 4, nb = q & 15, f0 = nb * 32;
            const float* W = (up ? F.in[29] : F.in[28]) + (size_t)e * D * 512;
            transpose_tile(W, 512, kb * 64, f0, GU, e * 1024 + (f0 >> 7) * 256 + up * 128 + (f0 & 127), D, kb * 64, scr, lane);
        } else {
            const int q = r - 512, kb = q >> 5, nb = q & 31;
            const float* W = F.in[30] + (size_t)e * 512 * D;
            transpose_tile(W, D, kb * 64, nb * 32, DN, e * 1024 + nb * 32, 512, kb * 64, scr, lane);
        }
    }
}
__device__ __forceinline__ void p10_scatter(Frame& F) {
    const int* toke = (const int*)(F.ws + WS_TOKE); const float* tokw = (const float*)(F.ws + WS_TOKW); int* toks = (int*)(F.ws + WS_TOKS); const int* tokr = (const int*)(F.ws + WS_TOKR);
    const unsigned* cntblk = (const unsigned*)(F.ws + WS_CNTBLK);
    float* slotw = (float*)(F.ws + WS_SLOTW); int* tilee = (int*)(F.ws + WS_TILEE);
    int* slott = (int*)(F.ws + WS_SLOTT);
    LAS int* part = (LAS int*)(F.lds);
    LAS int* ppre = part + 512;
    LAS int* segoff = ppre + 512;
    LAS int* mybase = segoff + 64;
    {
        const int e = F.tid & 31, p = F.tid >> 5; int tot = 0, pre = 0;
        for (int j = 0; j < 16; ++j) { const int bb = 16 * p + j; const int c = (bb < F.G) ? (int)cntblk[bb * 32 + e] : 0; tot += c; pre += (bb < F.vcu) ? c : 0; }
        part[p * 32 + e] = tot; ppre[p * 32 + e] = pre;
    }
    __syncthreads();
    if (F.tid < 32) { int tot = 0, pre = 0; for (int p = 0; p < 16; ++p) { tot += part[p * 32 + F.tid]; pre += ppre[p * 32 + F.tid]; } part[F.tid] = tot; ppre[F.tid] = pre; }
    __syncthreads();
    if (F.tid == 0) { int off = 0; for (int e = 0; e < 32; ++e) { segoff[e] = off; off += (part[e] + 255) & ~255; } segoff[32] = off; }
    __syncthreads();
    if (F.tid < 32) mybase[F.tid] = segoff[F.tid] + ppre[F.tid];
    if (blockIdx.x == 0 && F.tid < 32) { const int e = F.tid, t0 = segoff[e] >> 8, t1 = segoff[e + 1] >> 8; for (int i = t0; i < t1; ++i) tilee[i] = e; if (e == 31) tilee[MAXTILES] = t1; }
    __syncthreads();
    const int lane = F.lane, TPB = T / F.G;
    for (int q = F.wave; q < TPB * 2; q += NWAVES) {
        const int i = F.vcu * TPB * 2 + q;
        const int s = mybase[toke[i]] + tokr[i];
        if (lane == 0) { toks[i] = s; slotw[s] = tokw[i]; slott[s] = i >> 1; }
    }
    __syncthreads();
}
__device__ __forceinline__ void p13_final(Frame& F, float* dst) {
    const bf16_t* Y = (const bf16_t*)(F.ws + WS_Y); const int* toks = (const int*)(F.ws + WS_TOKS); const float* MOD = (const float*)(F.ws + WS_MOD); const float* fg = F.in[31];
    const int lane = F.lane;
    for (int t = F.gw; t < T; t += F.NGW) {
        const int b = t >> 13, s0 = toks[2 * t], s1 = toks[2 * t + 1];
        f32x4 v[4]; float ss = 0.f;
#pragma unroll
        for (int j = 0; j < 4; ++j) { const int col = 4 * lane + 256 * j;
            const f32x4 x = *(const GAS f32x4*)(F.out + (size_t)t * D + col), gt = *(const GAS f32x4*)(MOD + b * INW + 5120 + col);
            const unsigned long long ya = *(const GAS unsigned long long*)(Y + (size_t)s0 * D + col), yb = *(const GAS unsigned long long*)(Y + (size_t)s1 * D + col);
            f32x4 m;
            m.x = __uint_as_float((unsigned)ya << 16) + __uint_as_float((unsigned)yb << 16);
            m.y = __uint_as_float((unsigned)ya & 0xffff0000u) + __uint_as_float((unsigned)yb & 0xffff0000u);
            m.z = __uint_as_float((unsigned)(ya >> 32) << 16) + __uint_as_float((unsigned)(yb >> 32) << 16);
            m.w = __uint_as_float((unsigned)(ya >> 32) & 0xffff0000u) + __uint_as_float((unsigned)(yb >> 32) & 0xffff0000u);
            v[j] = x + gt * m; ss += (v[j].x * v[j].x + v[j].y * v[j].y) + (v[j].z * v[j].z + v[j].w * v[j].w); }
        const float rs = rsqrtf(wave_sum(ss) * (1.0f / D) + EPS);
#pragma unroll
        for (int j = 0; j < 4; ++j) { const int col = 4 * lane + 256 * j; const f32x4 g = *(const GAS f32x4*)(fg + col);
            *(GAS f32x4*)(dst + (size_t)t * D + col) = v[j] * rs * g; }
    }
}

#ifndef MK_REPMASK
#define MK_REPMASK 0
#endif
#ifndef MK_REP7A
#define MK_REP7A 0
#endif
#ifndef MK_REP7B
#define MK_REP7B 0
#endif
#ifndef MK_REP9W
#define MK_REP9W 0
#endif
#ifndef MK_BAR2
#define MK_BAR2 0
#endif
#ifndef MK_HYBRID
#define MK_HYBRID 0
#endif
__global__ void __launch_bounds__(NTHR, 2) mega(Args args) {
    extern __shared__ __attribute__((aligned(16))) unsigned char lds_raw[];
    Frame F;
    F.lds = (LAS unsigned char*)lds_raw;
    F.tid = threadIdx.x; F.lane = F.tid & 63; F.wave = __builtin_amdgcn_readfirstlane(F.tid >> 6);
    F.G = gridDim.x; { const int bx = blockIdx.x; F.vcu = (F.G % 8 == 0) ? (bx % 8) * (F.G / 8) + bx / 8 : bx; }
    F.gw = F.vcu * NWAVES + F.wave; F.NGW = F.G * NWAVES;
    F.in = args.in; F.out = args.out; F.ws = args.ws;
    volatile LAS unsigned* MISC = (volatile LAS unsigned*)(F.lds + MISC_OFF);
    if (F.tid < 64) MISC[F.tid] = 0u;
    __syncthreads();
    XcdBarrier bar = xcd_barrier_post((unsigned*)(F.ws + WS_CTL) + CW_BAR, MISC + 8);
    const int lo = args.ph_lo, hi = args.ph_hi;
#define IN(k) (lo <= (k) && (k) < hi)
#define REP(k) for (int rep_ = 0; rep_ < 1 + ((MK_REPMASK >> (k)) & 1); ++rep_)
#define SEAM(k) do { if (IN(k) && IN((k) + 1)) { xcd_barrier(bar); if (MK_BAR2) xcd_barrier(bar); } } while (0)
    if (IN(0)) REP(0) { p0_prologue(F); } SEAM(0);
    if (IN(1)) REP(1) { p1_prep<MK_HYBRID == 1>(F); for (int it = F.vcu; it < L / 32; it += F.G) p0_filter_item(F, it); } SEAM(1);
    if (IN(2)) REP(2) {
        pg8::Gemm g{(const bf16_t*)(F.ws + WS_HX), (const bf16_t*)(F.ws + WS_WIN_T), T, INW, D};
        pg8::StaticOrder S; S.init(T, INW, F.G, (int)blockIdx.x);
        pg8::EpiBf16Store E{(bf16_t*)(F.ws + WS_P), INW};
        pg8::gemm_phase<pg8::EpiBf16Store, pg8::StaticOrder, true, true>(F.lds, g, S, E);
    } SEAM(2);
    if (IN(3)) REP(3) {
        {
            pg8::Gemm g{(const bf16_t*)(F.ws + WS_HX) + (size_t)T * D, (const bf16_t*)(F.ws + WS_WIN_T) + (size_t)512 * D, TC, 1536, D};
            pg8::StaticOrder S; S.init(TC, 1536, F.G, F.vcu);
            pg8::EpiBf16Store E{(bf16_t*)(F.ws + WS_P) + (size_t)T * INW + 512, INW};
            pg8::gemm_phase<pg8::EpiBf16Store, pg8::StaticOrder, true, true>(F.lds, g, S, E);
        }
        gla_pass_a(F); hy_pre(F);
    } SEAM(3);
    if (IN(4)) REP(4) { hy_conv128(F); }
    if (IN(5)) REP(5) { gla_pass_b(F, (bf16_t*)F.out, (bf16_t*)F.out + (size_t)T * 512); } SEAM(5);
    if (IN(6)) REP(6) { p6_post(F, (const bf16_t*)F.out, (const bf16_t*)F.out + (size_t)T * 512, (bf16_t*)(F.ws + WS_YA), (bf16_t*)(F.ws + WS_YB)); } SEAM(6);
    if (IN(7)) {
        pg8::StaticOrder S; S.init(T, D, F.G, (int)blockIdx.x);
        const bf16_t* Pg = (const bf16_t*)(F.ws + WS_P) + C_GL;
        pg8::f32x4 macc[2][2][4][2];
        { pg8::Gemm g{(const bf16_t*)(F.ws + WS_YA), (const bf16_t*)(F.ws + WS_WA_T), T, D, 512};
          pg8::EpiMergeScale E{Pg};
          pg8::gemm_phase_acc<pg8::EpiMergeScale, pg8::StaticOrder, false, true, true>(F.lds, g, S, E, macc); }
        { pg8::Gemm g{(const bf16_t*)(F.ws + WS_YB), (const bf16_t*)(F.ws + WS_WB_T), T, D, 512};
          pg8::EpiMergeOut E{(bf16_t*)(F.ws + WS_MIXED), Pg};
          pg8::gemm_phase_acc<pg8::EpiMergeOut, pg8::StaticOrder, true, true, false>(F.lds, g, S, E, macc); }
    } SEAM(7);
    if (IN(8)) REP(8) {
        pg8::Gemm g{(const bf16_t*)(F.ws + WS_MIXED), (const bf16_t*)(F.ws + WS_WO_T), T, D, D};
        pg8::StaticOrder S; S.init(T, D, F.G, (int)blockIdx.x);
        pg8::EpiX1 E{F.in[0], F.out, (const float*)(F.ws + WS_MOD) + 2048, (const float*)(F.ws + WS_PER), (const float*)(F.ws + WS_PEC)};
        pg8::gemm_phase<pg8::EpiX1, pg8::StaticOrder, true, true>(F.lds, g, S, E);
    } SEAM(8);
    if (IN(9)) { REP(9) p9_router(F); for (int rw_ = 0; rw_ < 1 + MK_REP9W; ++rw_) p9_weights(F); } SEAM(9);
    if (IN(10)) REP(10) { p10_scatter(F); } SEAM(10);
    if (IN(11)) REP(11) {
        const int* tilee = (const int*)(F.ws + WS_TILEE);
        pg8::Gemm g{(const bf16_t*)(F.ws + WS_H2), (const bf16_t*)(F.ws + WS_GU_T), 0, 0, D, (const int*)(F.ws + WS_SLOTT)};
        pg8::MoeOrder S{tilee, tilee[MAXTILES], F.G, F.vcu};
        pg8::EpiHid E{(bf16_t*)(F.ws + WS_HID), (const float*)(F.ws + WS_SLOTW)};
        pg8::f32x4 gacc[2][2][4][2];
        pg8::gemm_phase_acc<pg8::EpiHid, pg8::MoeOrder, true, true, true, true>(F.lds, g, S, E, gacc);
    } SEAM(11);
    if (IN(12)) REP(12) {
        const int* tilee = (const int*)(F.ws + WS_TILEE);
        pg8::Gemm g{(const bf16_t*)(F.ws + WS_HID), (const bf16_t*)(F.ws + WS_DN_T), 0, 0, 512};
        pg8::MoeOrder S{tilee, tilee[MAXTILES], F.G, F.vcu};
        pg8::EpiY E{(bf16_t*)(F.ws + WS_Y)};
        pg8::gemm_phase<pg8::EpiY, pg8::MoeOrder, true, true>(F.lds, g, S, E);
    } SEAM(12);
    if (IN(13)) REP(13) { p13_final(F, (rep_ == ((MK_REPMASK >> 13) & 1)) ? F.out : (float*)(F.ws + WS_GU_T)); }
#undef IN
#undef SEAM
}
}

extern "C" void kernel_launch(void* const* d_in, const int* in_sizes, int n_in, void* d_out, int out_size, void* d_ws, size_t ws_size, hipStream_t stream) {
    using namespace mk;
    static int grid = 0;
    if (grid == 0) {
        if (n_in != 32 || ws_size < 312 * MiB) { fprintf(stderr, "kernel_launch: unexpected n_in %d or ws_size %zu\n", n_in, ws_size); grid = -1; return; }
        int dev = 0, cus = 0, per_cu = 0;
        if (hipGetDevice(&dev) != hipSuccess || hipDeviceGetAttribute(&cus, hipDeviceAttributeMultiprocessorCount, dev) != hipSuccess) { grid = -1; return; }
        if (hipFuncSetAttribute((const void*)mega, hipFuncAttributeMaxDynamicSharedMemorySize, LDS_BYTES) != hipSuccess) { fprintf(stderr, "kernel_launch: hipFuncSetAttribute failed\n"); grid = -1; return; }
        if (hipOccupancyMaxActiveBlocksPerMultiprocessor(&per_cu, (const void*)mega, NTHR, LDS_BYTES) != hipSuccess || per_cu < 1) { fprintf(stderr, "kernel_launch: occupancy query says %d\n", per_cu); }
        (void)hipGetLastError();
        grid = cus;
    }
    if (grid < 0) return;
    (void)hipMemsetAsync((char*)d_ws + WS_CTL, 0, CTL_ZERO_BYTES, stream);
    Args a{};
    for (int i = 0; i < 32; ++i) a.in[i] = (const float*)d_in[i];
    a.out = (float*)d_out; a.ws = (unsigned char*)d_ws; a.ph_lo = 0; a.ph_hi = 14;
    hipLaunchKernelGGL(mega, dim3(grid), dim3(NTHR), LDS_BYTES, stream, a);
#if MK_HYBRID == 2
    nv::tail_from_YAB(d_in, d_out, d_ws, stream);
#endif
}
```
